# Optimizing an MI355X kernel written in HIP

```python
import math
import jax, jax.numpy as jnp
from jax import lax
import numpy as np

D_MODEL = 1024
BATCH = 4
SEQ = 8192
DEPTH = 2

HEAD_DIM = 64
A_HEADS = D_MODEL // (2 * HEAD_DIM)
B_HEADS = D_MODEL // (4 * HEAD_DIM)
C_HEADS = D_MODEL // (2 * HEAD_DIM)
D_HEADS = D_MODEL // (2 * HEAD_DIM)
D_KV_HEADS = D_HEADS // 4
A_W = A_HEADS * HEAD_DIM
B_W = B_HEADS * 2 * HEAD_DIM
C_W = C_HEADS * HEAD_DIM
D_W = D_HEADS * HEAD_DIM
D_KV_W = D_KV_HEADS * HEAD_DIM
EVEN_WIDTH = A_W + B_W
ODD_WIDTH = C_W + D_W
EVEN_SPLITS = (A_W, A_W, A_W, A_W, B_W, B_W, B_W, B_W)
ODD_SPLITS = (C_W, C_W, C_W, C_W, D_W, D_KV_W, D_KV_W, D_KV_W, D_KV_W, D_KV_W, D_KV_W, D_W, 3 * D_HEADS)
EVEN_COLS = 4 * A_W + 4 * B_W
ODD_COLS = 4 * C_W + 2 * D_W + 6 * D_KV_W + 3 * D_HEADS
N_EVEN = (DEPTH + 1) // 2
N_ODD = DEPTH // 2
DILATED_PATTERNS = ((128, 1), (512, 4), (2048, 16))
BAND_BLK = 128
DENSE_BLK = 128
MOBA_BLK = 256
MOBA_TOPK = 3
MOBA_CQ = 32
CMP_LEN = 32
CMP_STRIDE = 16
CMP_HIDDEN = 2 * HEAD_DIM
SLC_BLK = 64
SLC_TOPK = 16
NSA_WINDOW = 512
NSA_CQ = 64
RMS_EPS = 1e-6

kernel_name = 'hybrid_dilated_diff_moba_nsa'


def rmsnorm(x, g):
    xf = x.astype(jnp.float32)
    y = xf * lax.rsqrt(jnp.mean(xf * xf, axis=-1, keepdims=True) + RMS_EPS)
    return (y * g.astype(jnp.float32)).astype(x.dtype)


def alibi_slopes(n):
    return jnp.exp2(-8.0 * jnp.arange(1, n + 1, dtype=jnp.float32) / n)


def split_cols(h, sizes):
    out, off = [], 0
    for s in sizes:
        out.append(h[..., off:off + s])
        off += s
    return out


def softmax_parts(s, mask):
    s = jnp.where(mask, s, -jnp.inf)
    m = jnp.max(s, axis=-1, keepdims=True)
    m = jnp.where(jnp.isfinite(m), m, 0.0)
    p = jnp.exp(s - m)
    return p, m, jnp.sum(p, axis=-1, keepdims=True)


def take_blocks(blocks, idx):
    return jax.vmap(jax.vmap(lambda t, i: t[i]))(blocks, idx)


def banded_attention(q, k, v, max_dist, slopes, dist_scale=1):
    N, L, Hq, dh = q.shape
    Hkv = k.shape[2]
    G = Hq // Hkv
    nb = L // BAND_BLK
    nprev = -(-max_dist // BAND_BLK)
    C = (nprev + 1) * BAND_BLK

    def band(t):
        tb = jnp.pad(t.reshape(N, nb, BAND_BLK, Hkv, dh), ((0, 0), (nprev, 0), (0, 0), (0, 0), (0, 0)))
        return jnp.concatenate([tb[:, i:i + nb] for i in range(nprev + 1)], axis=2)

    kb, vb = band(k), band(v)
    qb = q.reshape(N, nb, BAND_BLK, Hkv, G, dh)
    s = jnp.einsum('nbqhgd,nbchd->nbhgqc', qb, kb, preferred_element_type=jnp.float32) * dh ** -0.5
    dist = jnp.arange(BAND_BLK)[:, None] + nprev * BAND_BLK - jnp.arange(C)[None, :]
    kglob = jnp.arange(nb)[:, None] * BAND_BLK - nprev * BAND_BLK + jnp.arange(C)[None, :]
    mask = ((dist >= 0) & (dist <= max_dist))[None, None, None, None] & (kglob >= 0)[None, :, None, None, None, :]
    bias = -slopes.astype(jnp.float32).reshape(Hkv, G, 1, 1) * (dist * dist_scale).astype(jnp.float32)
    p, m, l = softmax_parts(s + bias, mask)
    o = jnp.einsum('nbhgqc,nbchd->nbhgqd', p.astype(v.dtype), vb, preferred_element_type=jnp.float32) / l
    o = o.transpose(0, 1, 4, 2, 3, 5).reshape(N, L, Hq, dh)
    stat = lambda t: t[..., 0].transpose(0, 1, 4, 2, 3).reshape(N, L, Hq)
    return o, stat(m), stat(l)


def dilated_attention(q, k, v, slopes):
    B, S, H, dh = q.shape
    outs, maxes, dens = [], [], []
    for window, dil in DILATED_PATTERNS:
        span = dil * BAND_BLK
        Sp = -(-S // span) * span
        Lp = Sp // dil

        def to_phase(t):
            t = jnp.pad(t, ((0, 0), (0, Sp - S), (0, 0), (0, 0)))
            return jnp.swapaxes(t.reshape(B, Lp, dil, H, dh), 1, 2).reshape(B * dil, Lp, H, dh)

        def from_phase(t):
            rest = t.shape[2:]
            t = jnp.swapaxes(t.reshape(B, dil, Lp, *rest), 1, 2).reshape(B, Sp, *rest)
            return t[:, :S]

        o, m, l = banded_attention(to_phase(q), to_phase(k), to_phase(v), window // dil, slopes, dil)
        outs.append(from_phase(o))
        maxes.append(from_phase(m))
        dens.append(from_phase(l))
    m_all = jnp.stack(maxes)
    w = jnp.stack(dens) * jnp.exp(m_all - jnp.max(m_all, axis=0, keepdims=True))
    w = w / jnp.sum(w, axis=0, keepdims=True)
    return jnp.sum(w[..., None] * jnp.stack(outs), axis=0)


def diff_attention(q, k, v, lam, slopes):
    B, S, H, _, dh = q.shape
    nq = S // DENSE_BLK
    qb = jnp.moveaxis(q.reshape(B, nq, DENSE_BLK, H, 2, dh), 1, 0)
    kpos = jnp.arange(S)
    sl = slopes[None, :, None, None, None]

    def block(args):
        qi, i = args
        s = jnp.einsum('bqhcd,bkhcd->bhcqk', qi, k, preferred_element_type=jnp.float32) * dh ** -0.5
        dist = (i * DENSE_BLK + jnp.arange(DENSE_BLK))[:, None] - kpos[None, :]
        s = jnp.where(dist >= 0, s - sl * dist.astype(jnp.float32), -jnp.inf)
        p = jax.nn.softmax(s, axis=-1)
        a = p[:, :, 0] - lam * p[:, :, 1]
        return jnp.einsum('bhqk,bkhe->bqhe', a.astype(v.dtype), v, preferred_element_type=jnp.float32)

    o = lax.map(block, (qb, jnp.arange(nq)))
    return jnp.moveaxis(o, 0, 1).reshape(B, S, H, 2 * dh)


def moba_attention(q, k, v, slopes):
    B, S, H, dh = q.shape
    Sp = -(-S // MOBA_BLK) * MOBA_BLK
    pad = ((0, 0), (0, Sp - S), (0, 0), (0, 0))
    q, k, v = jnp.pad(q, pad), jnp.pad(k, pad), jnp.pad(v, pad)
    nblk = Sp // MOBA_BLK
    kbh = k.reshape(B, nblk, MOBA_BLK, H, dh).transpose(0, 3, 1, 2, 4)
    vbh = v.reshape(B, nblk, MOBA_BLK, H, dh).transpose(0, 3, 1, 2, 4)
    kmean = jnp.mean(kbh.astype(jnp.float32), axis=3)
    gate = jnp.einsum('bshd,bhnd->bhsn', q.astype(jnp.float32), kmean)
    past = jnp.arange(nblk)[None, :] < (jnp.arange(Sp) // MOBA_BLK)[:, None]
    n_sel = min(MOBA_TOPK, nblk)
    _, idx = lax.top_k(jnp.where(past, gate, -jnp.inf), n_sel)
    nch = Sp // MOBA_CQ
    qs = jnp.moveaxis(q.reshape(B, nch, MOBA_CQ, H, dh), 1, 0)
    idxs = idx.reshape(B, H, nch, MOBA_CQ, n_sel).transpose(2, 0, 1, 3, 4)
    scale = dh ** -0.5

    def chunk(args):
        qc, ic, c = args
        qpos = c * MOBA_CQ + jnp.arange(MOBA_CQ)
        own = (c * MOBA_CQ) // MOBA_BLK
        k_own = lax.dynamic_index_in_dim(kbh, own, axis=2, keepdims=False)
        v_own = lax.dynamic_index_in_dim(vbh, own, axis=2, keepdims=False)
        k_sel = take_blocks(kbh, ic)
        v_sel = take_blocks(vbh, ic)
        kpos_sel = ic[..., None] * MOBA_BLK + jnp.arange(MOBA_BLK)
        s_sel = jnp.einsum('bqhd,bhqnkd->bhqnk', qc, k_sel, preferred_element_type=jnp.float32) * scale
        s_sel = s_sel - slopes[None, :, None, None, None] * (qpos[None, None, :, None, None] - kpos_sel).astype(jnp.float32)
        valid_sel = jnp.broadcast_to((ic < own)[..., None], s_sel.shape)
        kpos_own = own * MOBA_BLK + jnp.arange(MOBA_BLK)
        s_own = jnp.einsum('bqhd,bhkd->bhqk', qc, k_own, preferred_element_type=jnp.float32) * scale
        s_own = s_own - slopes[None, :, None, None] * (qpos[:, None] - kpos_own[None, :]).astype(jnp.float32)
        mask_own = jnp.broadcast_to(kpos_own[None, :] <= qpos[:, None], s_own.shape)
        nk = n_sel * MOBA_BLK
        s = jnp.concatenate([s_sel.reshape(B, H, MOBA_CQ, nk), s_own], axis=-1)
        mask = jnp.concatenate([valid_sel.reshape(B, H, MOBA_CQ, nk), mask_own], axis=-1)
        p = jax.nn.softmax(jnp.where(mask, s, -jnp.inf), axis=-1)
        p_sel = p[..., :nk].reshape(B, H, MOBA_CQ, n_sel, MOBA_BLK).astype(v.dtype)
        p_own = p[..., nk:].astype(v.dtype)
        return (jnp.einsum('bhqnk,bhqnkd->bqhd', p_sel, v_sel, preferred_element_type=jnp.float32)
                + jnp.einsum('bhqk,bhkd->bqhd', p_own, v_own, preferred_element_type=jnp.float32))

    o = lax.map(chunk, (qs, idxs, jnp.arange(nch)))
    return jnp.moveaxis(o, 0, 1).reshape(B, Sp, H, dh)[:, :S]


def compress_blocks(t, pe, w1, w2):
    B, S, Hkv, dh = t.shape
    n_cmp = (S - CMP_LEN) // CMP_STRIDE + 1
    r = CMP_LEN // CMP_STRIDE
    ch = t.reshape(B, S // CMP_STRIDE, CMP_STRIDE, Hkv, dh)
    blocks = jnp.concatenate([ch[:, i:i + n_cmp] for i in range(r)], axis=2) + pe[None, None, :, None, :]
    flat = blocks.transpose(0, 1, 3, 2, 4).reshape(B, n_cmp, Hkv, CMP_LEN * dh)
    return jax.nn.silu(flat @ w1) @ w2


def nsa_attention(q, k_cmp, v_cmp, k_slc, v_slc, k_win, v_win, gates, slopes):
    B, S, Hq, dh = q.shape
    Hkv = k_slc.shape[2]
    G = Hq // Hkv
    n_cmp = k_cmp.shape[1]
    n_slc = S // SLC_BLK
    n_top = min(SLC_TOPK, n_slc)
    scale = dh ** -0.5
    cstart = jnp.arange(n_cmp) * CMP_STRIDE
    cend = cstart + CMP_LEN - 1
    sstart = jnp.arange(n_slc) * SLC_BLK
    cmp_in_slc = ((cstart[:, None] <= sstart[None, :] + SLC_BLK - 1) & (cend[:, None] >= sstart[None, :])).astype(jnp.float32)
    ksb = k_slc.reshape(B, n_slc, SLC_BLK, Hkv, dh).transpose(0, 3, 1, 2, 4)
    vsb = v_slc.reshape(B, n_slc, SLC_BLK, Hkv, dh).transpose(0, 3, 1, 2, 4)
    sl = slopes.reshape(Hkv, G)
    nch = S // NSA_CQ
    qs = jnp.moveaxis(q.reshape(B, nch, NSA_CQ, Hkv, G, dh), 1, 0)
    jb = jnp.arange(n_slc)[None, :]

    def chunk(args):
        qc, c = args
        qpos = c * NSA_CQ + jnp.arange(NSA_CQ)
        s = jnp.einsum('bqhgd,bnhd->bhgqn', qc, k_cmp, preferred_element_type=jnp.float32) * scale
        s = s - sl[:, :, None, None] * (qpos[:, None] - cend[None, :]).astype(jnp.float32)
        p, _, l = softmax_parts(s, cend[None, :] <= qpos[:, None])
        p = p / jnp.where(l > 0, l, 1.0)
        o_cmp = jnp.einsum('bhgqn,bnhd->bqhgd', p.astype(v_cmp.dtype), v_cmp, preferred_element_type=jnp.float32)
        imp = jnp.einsum('bhgqn,nj->bhqj', p, cmp_in_slc)
        qb = (qpos // SLC_BLK)[:, None]
        forced = (jb == 0) | (jb == qb) | (jb == qb - 1)
        imp = jnp.where(forced, jnp.inf, jnp.where(jb > qb, -jnp.inf, imp))
        _, idx = lax.top_k(imp, n_top)
        k_sel = take_blocks(ksb, idx)
        v_sel = take_blocks(vsb, idx)
        dist = qpos[None, None, :, None, None] - (idx[..., None] * SLC_BLK + jnp.arange(SLC_BLK))
        s2 = jnp.einsum('bqhgd,bhqnkd->bhgqnk', qc, k_sel, preferred_element_type=jnp.float32) * scale
        s2 = s2 - sl[None, :, :, None, None, None] * dist[:, :, None].astype(jnp.float32)
        mask2 = jnp.broadcast_to((dist >= 0)[:, :, None], s2.shape)
        nk = n_top * SLC_BLK
        p2 = jax.nn.softmax(jnp.where(mask2, s2, -jnp.inf).reshape(B, Hkv, G, NSA_CQ, nk), axis=-1)
        p2 = p2.reshape(B, Hkv, G, NSA_CQ, n_top, SLC_BLK).astype(v_sel.dtype)
        o_slc = jnp.einsum('bhgqnk,bhqnkd->bqhgd', p2, v_sel, preferred_element_type=jnp.float32)
        return o_cmp, o_slc

    o_cmp, o_slc = lax.map(chunk, (qs, jnp.arange(nch)))
    o_cmp = jnp.moveaxis(o_cmp, 0, 1).reshape(B, S, Hq, dh)
    o_slc = jnp.moveaxis(o_slc, 0, 1).reshape(B, S, Hq, dh)
    o_win, _, _ = banded_attention(q, k_win, v_win, NSA_WINDOW - 1, slopes)
    g = gates.astype(jnp.float32)
    return g[..., 0:1] * o_cmp + g[..., 1:2] * o_slc + g[..., 2:3] * o_win


def even_layer(x, ln, w_in, qkn, lam, subln, w_out, layer):
    B, S, _ = x.shape
    h = rmsnorm(x, ln)
    aq, ak, av, az, bq, bk, bv, bz = split_cols(h @ w_in, EVEN_SPLITS)
    heads = lambda t, n: t.reshape(B, S, n, -1)
    oa = dilated_attention(rmsnorm(heads(aq, A_HEADS), qkn[0]), rmsnorm(heads(ak, A_HEADS), qkn[1]),
                           heads(av, A_HEADS), alibi_slopes(A_HEADS)).astype(x.dtype)
    bq = rmsnorm(bq.reshape(B, S, B_HEADS, 2, HEAD_DIM), qkn[2])
    bk = rmsnorm(bk.reshape(B, S, B_HEADS, 2, HEAD_DIM), qkn[3])
    lam_init = 0.8 - 0.6 * math.exp(-0.3 * layer)
    lf = lam.astype(jnp.float32)
    lam_f = jnp.exp(jnp.sum(lf[0] * lf[1])) - jnp.exp(jnp.sum(lf[2] * lf[3])) + lam_init
    ob = diff_attention(bq, bk, heads(bv, B_HEADS), lam_f, alibi_slopes(B_HEADS))
    ob = (rmsnorm(ob, subln) * (1.0 - lam_init)).astype(x.dtype)
    mixed = jnp.concatenate([oa.reshape(B, S, A_W) * jax.nn.silu(az),
                             ob.reshape(B, S, B_W) * jax.nn.silu(bz)], axis=-1)
    return x + mixed @ w_out


def odd_layer(x, ln, w_in, qkn, phi_pe, phi_w1, phi_w2, w_out):
    B, S, _ = x.shape
    h = rmsnorm(x, ln)
    cq, ck, cv, cz, dq, dkc, dvc, dks, dvs, dkw, dvw, dz, dg = split_cols(h @ w_in, ODD_SPLITS)
    heads = lambda t, n: t.reshape(B, S, n, HEAD_DIM)
    oc = moba_attention(rmsnorm(heads(cq, C_HEADS), qkn[0]), rmsnorm(heads(ck, C_HEADS), qkn[1]),
                        heads(cv, C_HEADS), alibi_slopes(C_HEADS)).astype(x.dtype)
    k_cmp = rmsnorm(compress_blocks(heads(dkc, D_KV_HEADS), phi_pe[0], phi_w1[0], phi_w2[0]), qkn[3])
    v_cmp = compress_blocks(heads(dvc, D_KV_HEADS), phi_pe[1], phi_w1[1], phi_w2[1])
    od = nsa_attention(rmsnorm(heads(dq, D_HEADS), qkn[2]), k_cmp, v_cmp,
                       rmsnorm(heads(dks, D_KV_HEADS), qkn[4]), heads(dvs, D_KV_HEADS),
                       rmsnorm(heads(dkw, D_KV_HEADS), qkn[5]), heads(dvw, D_KV_HEADS),
                       jax.nn.sigmoid(dg.reshape(B, S, D_HEADS, 3)), alibi_slopes(D_HEADS)).astype(x.dtype)
    mixed = jnp.concatenate([oc.reshape(B, S, C_W) * jax.nn.silu(cz),
                             od.reshape(B, S, D_W) * jax.nn.silu(dz)], axis=-1)
    return x + mixed @ w_out


def setup_inputs(seed: int = 0) -> dict:
    key = jax.random.key(seed)
    ks = jax.random.split(key, 14)
    nrm = lambda k, shape: jax.random.normal(k, shape, jnp.float32)
    w = lambda k, shape, fan_in: nrm(k, shape) * fan_in ** -0.5
    gain = lambda k, shape: 1.0 + 0.05 * nrm(k, shape)
    return {
        'x': nrm(ks[0], (BATCH, SEQ, D_MODEL)),
        'ln_e': gain(ks[1], (N_EVEN, D_MODEL)),
        'w_in_e': w(ks[2], (N_EVEN, D_MODEL, EVEN_COLS), D_MODEL),
        'qkn_e': gain(ks[3], (N_EVEN, 4, HEAD_DIM)),
        'lam_e': 0.1 * nrm(ks[4], (N_EVEN, 4, HEAD_DIM)),
        'subln_e': gain(ks[5], (N_EVEN, 2 * HEAD_DIM)),
        'w_out_e': w(ks[6], (N_EVEN, EVEN_WIDTH, D_MODEL), EVEN_WIDTH),
        'ln_o': gain(ks[7], (N_ODD, D_MODEL)),
        'w_in_o': w(ks[8], (N_ODD, D_MODEL, ODD_COLS), D_MODEL),
        'qkn_o': gain(ks[9], (N_ODD, 6, HEAD_DIM)),
        'phi_pe': 0.1 * nrm(ks[10], (N_ODD, 2, CMP_LEN, HEAD_DIM)),
        'phi_w1': w(ks[11], (N_ODD, 2, CMP_LEN * HEAD_DIM, CMP_HIDDEN), CMP_LEN * HEAD_DIM),
        'phi_w2': w(ks[12], (N_ODD, 2, CMP_HIDDEN, HEAD_DIM), CMP_HIDDEN),
        'w_out_o': w(ks[13], (N_ODD, ODD_WIDTH, D_MODEL), ODD_WIDTH),
    }


def reference(x, ln_e, w_in_e, qkn_e, lam_e, subln_e, w_out_e, ln_o, w_in_o, qkn_o,
              phi_pe, phi_w1, phi_w2, w_out_o):
    for layer in range(DEPTH):
        i = layer // 2
        if layer % 2 == 0:
            x = even_layer(x, ln_e[i], w_in_e[i], qkn_e[i], lam_e[i], subln_e[i], w_out_e[i], layer)
        else:
            x = odd_layer(x, ln_o[i], w_in_o[i], qkn_o[i], phi_pe[i], phi_w1[i], phi_w2[i], w_out_o[i])
    return x
```

```cpp
#include <hip/hip_runtime.h>
#include <hip/hip_cooperative_groups.h>
#include <cstdio>
#include <cstdint>
namespace cg = cooperative_groups;

#ifndef MK_LAUNCHES
#define MK_LAUNCHES 1
#endif

#ifndef EN_A
#define EN_A 1
#endif
#ifndef EN_B
#define EN_B 1
#endif
#ifndef EN_C
#define EN_C 1
#endif
#ifndef EN_D
#define EN_D 1
#endif
#ifndef EN_G
#define EN_G 1
#endif
#ifndef EN_P
#define EN_P 1
#endif
#define LAS __attribute__((address_space(3)))
typedef unsigned short bf16_t;
typedef short bf16x8 __attribute__((ext_vector_type(8)));
typedef short s16x4 __attribute__((ext_vector_type(4)));
typedef float f32x4 __attribute__((ext_vector_type(4)));
typedef float f32x16 __attribute__((ext_vector_type(16)));
typedef unsigned u32x4 __attribute__((ext_vector_type(4)));
typedef unsigned u32x2 __attribute__((ext_vector_type(2)));
typedef float f32x2_t __attribute__((ext_vector_type(2)));
typedef __bf16 bf16x2_t __attribute__((ext_vector_type(2)));

constexpr int BATCH = 4, SEQ = 8192, DM = 1024, MTOK = BATCH * SEQ, PQ = 4096;
constexpr int ODD_N = 3864;
constexpr float EPS = 1e-6f, LOG2E = 1.4426950408889634f, C2 = 0.125f * LOG2E;
constexpr float THR = 8.0f;
constexpr int NWAVES = 8, NTHREADS = 512;

constexpr size_t MiB = 1u << 20;
constexpr size_t WS_CTL = 0, CTL_BYTES = 4096;
constexpr size_t WS_WIN_E = 2 * MiB, WS_WOUT_E = 10 * MiB, WS_WIN_O = 12 * MiB, WS_WOUT_O = 20 * MiB;
constexpr size_t WS_W1T = 22 * MiB, WS_W2T = 23 * MiB, WS_BIAS1 = 23 * MiB + 65536, WS_KMEAN = 23 * MiB + 131072;
constexpr size_t WS_KCMP = 24 * MiB, WS_VCMP = 24 * MiB + 524288;
constexpr size_t WS_SSQ0 = 26 * MiB, WS_SSQ1 = 28 * MiB;
constexpr size_t WS_XN = 32 * MiB, WS_MIXED = 96 * MiB, WS_QKV = 160 * MiB, WS_END = 416 * MiB;

constexpr int RING_BYTES = 131072, LDSCTL_OFF = 143360, LDS_BYTES = 147456;

__device__ __forceinline__ unsigned f2bf(float f) { unsigned u = __builtin_bit_cast(unsigned, f); return (u + 0x7fffu + ((u >> 16) & 1u)) >> 16; }
__device__ __forceinline__ unsigned pk2(float lo, float hi) { return f2bf(lo) | (f2bf(hi) << 16); }
__device__ __forceinline__ float bf2f(unsigned b) { return __builtin_bit_cast(float, b << 16); }
__device__ __forceinline__ unsigned cvtpk(float lo, float hi) { f32x2_t v = {lo, hi}; bf16x2_t b = __builtin_convertvector(v, bf16x2_t); return __builtin_bit_cast(unsigned, b); }
__device__ __forceinline__ int crow(int r, int hi) { return (r & 3) + 8 * (r >> 2) + 4 * hi; }
__device__ __forceinline__ float wave_sum(float v) {
#pragma unroll
    for (int o = 1; o < 64; o <<= 1) v += __shfl_xor(v, o);
    return v;
}
__device__ __forceinline__ float swap_add(float v) { auto rr = __builtin_amdgcn_permlane32_swap(__float_as_uint(v), __float_as_uint(v), false, false); return __uint_as_float(rr[0]) + __uint_as_float(rr[1]); }
__device__ __forceinline__ float swap_max(float v) { auto rr = __builtin_amdgcn_permlane32_swap(__float_as_uint(v), __float_as_uint(v), false, false); return fmaxf(__uint_as_float(rr[0]), __uint_as_float(rr[1])); }
__device__ __forceinline__ void glds16(const void* g, LAS void* l) { __builtin_amdgcn_global_load_lds((const unsigned*)g, (LAS unsigned*)l, 16, 0, 0); }
#define LDS_WAIT() asm volatile("s_waitcnt lgkmcnt(0)" ::: "memory")
#define VM_WAIT() asm volatile("s_waitcnt vmcnt(0)" ::: "memory")

namespace pg8 {
constexpr int BM = 256, BK = 64, HALF = 128, HTB = HALF * BK * 2, NXCD = 8, WGM = 8;
__host__ __device__ __forceinline__ int lds_byte(int r, int c) { const int st = (r >> 4) * 2 + (c >> 5), rr = r & 15, cc = c & 31, ob = rr * 64 + cc * 2; return st * 1024 + (ob ^ (((ob >> 9) & 1) << 5)); }
__host__ __device__ __forceinline__ void stage_rc(int b, int& R, int& C) { const int st = b / 1024, sb = b % 1024, swz = sb ^ (((sb >> 9) & 1) << 5); R = (st >> 1) * 16 + swz / 64; C = (st & 1) * 32 + (swz % 64) / 2; }
__host__ __device__ __forceinline__ int perm32(int rho) { const int n = rho >> 4, i = rho & 15; return 8 * (i >> 2) + 4 * n + (i & 3); }
struct Unit { int pm, pn; };
struct Gemm { const bf16_t* A; const bf16_t* Bt; int M, N, K; };
struct StaticOrder {
    int nM, nN, nwg, G, c;
    __device__ void init(int M, int N, int G_, int c_) { nM = M / BM; nN = N / BM; nwg = nM * nN; G = G_; c = c_; }
    __device__ bool next(int i, Unit& u) const {
        const long L = (long)i * G + c; if (L >= nwg) return false;
        int wgid = (int)L; { const int q = nwg / NXCD, r = nwg % NXCD, xcd = wgid % NXCD, off = wgid / NXCD; wgid = (xcd < r ? xcd * (q + 1) : r * (q + 1) + (xcd - r) * q) + off; }
        const int nig = WGM * nN, gid = wgid / nig, fm = gid * WGM, gsz = (nM - fm) < WGM ? (nM - fm) : WGM;
        u.pm = fm + ((wgid % nig) % gsz); u.pn = (wgid % nig) / gsz; return true;
    }
};

template <class Epi>
__device__ __forceinline__ void gemm_phase(LAS unsigned char* lds, const Gemm g, const StaticOrder& S, const Epi& E) {
    const int tid = threadIdx.x, wid = __builtin_amdgcn_readfirstlane(tid >> 6), lane = tid & 63, wr = wid >> 2, wc = wid & 3, fr = lane & 15, fq = lane >> 4;
    const int K = g.K, nt = K / BK;
    unsigned voffA[2], voffB[2];
#pragma unroll
    for (int i = 0; i < 2; ++i) { int R, C; stage_rc(tid * 16 + i * 8192, R, C); const int Rb = Epi::PERM ? ((R & ~31) + perm32(R & 31)) : R;
        voffA[i] = (unsigned)(R * K + C) * 2u; voffB[i] = (unsigned)(Rb * K + C) * 2u; }
    const size_t kstep = (size_t)(BK * 2);
    const size_t hstep = (size_t)HALF * K * 2;
    const size_t tstep = 2 * hstep;
    const unsigned ldsw = (unsigned)wid * 1024u;
    const int aoff = lds_byte(wr * 64 + fr, fq * 8), boff = lds_byte(wc * 32 + fr, fq * 8);
#define PG8_SA(b, h) (((b) * 2 + (h)) * HTB)
#define PG8_SB(b, h) ((4 + (b) * 2 + (h)) * HTB)
#define PG8_STAGE(bufoff, gbase, voff) do { _Pragma("unroll") for (int _i = 0; _i < 2; ++_i) \
        __builtin_amdgcn_global_load_lds((const unsigned*)((const char*)(gbase) + (voff)[_i]), (LAS unsigned*)(lds + (bufoff) + ldsw + _i * 8192), 16, 0, 0); } while (0)
#define PG8_LDA(dst, b, h) do { _Pragma("unroll") for (int m = 0; m < 4; ++m) _Pragma("unroll") for (int k = 0; k < 2; ++k) dst[m][k] = *(const LAS bf16x8*)(lds + PG8_SA(b, h) + aoff + m * 2048 + k * 1024); } while (0)
#define PG8_LDB(dst, b, h) do { _Pragma("unroll") for (int n = 0; n < 2; ++n) _Pragma("unroll") for (int k = 0; k < 2; ++k) dst[n][k] = *(const LAS bf16x8*)(lds + PG8_SB(b, h) + boff + n * 2048 + k * 1024); } while (0)
#define PG8_MMA(ai, bj, At, Bt) do { __builtin_amdgcn_s_setprio(1); _Pragma("unroll") for (int m = 0; m < 4; ++m) _Pragma("unroll") for (int n = 0; n < 2; ++n) _Pragma("unroll") for (int k = 0; k < 2; ++k) \
        acc[ai][bj][m][n] = __builtin_amdgcn_mfma_f32_16x16x32_bf16(Bt[n][k], At[m][k], acc[ai][bj][m][n], 0, 0, 0); __builtin_amdgcn_s_setprio(0); } while (0)
#define PG8_WAIT_V(n) asm volatile("s_waitcnt vmcnt(" #n ")" ::: "memory")
#define PG8_WAIT_L(n) asm volatile("s_waitcnt lgkmcnt(" #n ")" ::: "memory")
#define PG8_BAR __builtin_amdgcn_s_barrier()
#define PG8_SCHED __builtin_amdgcn_sched_barrier(0)
    Unit cur, nxt; int ui = 0;
    if (!S.next(0, cur)) return;
    f32x4 acc[2][2][4][2];
#pragma unroll
    for (int a = 0; a < 2; ++a)
#pragma unroll
        for (int b = 0; b < 2; ++b)
#pragma unroll
            for (int m = 0; m < 4; ++m)
#pragma unroll
                for (int n = 0; n < 2; ++n) acc[a][b][m][n] = (f32x4){0.f, 0.f, 0.f, 0.f};
    bf16x8 At[4][2], B0[2][2], B1[2][2];
    const char* cA = (const char*)g.A + (size_t)cur.pm * tstep; const char* cB = (const char*)g.Bt + (size_t)cur.pn * tstep;
    PG8_STAGE(PG8_SB(0, 0), cB, voffB); PG8_STAGE(PG8_SB(0, 1), cB + hstep, voffB); PG8_STAGE(PG8_SA(0, 0), cA, voffA); PG8_STAGE(PG8_SA(0, 1), cA + hstep, voffA);
    if (wr == 1) PG8_BAR;
    PG8_WAIT_V(2); PG8_BAR;
    PG8_STAGE(PG8_SB(1, 0), cB + kstep, voffB); PG8_STAGE(PG8_SA(1, 0), cA + kstep, voffA); PG8_STAGE(PG8_SB(1, 1), cB + hstep + kstep, voffB);
    PG8_WAIT_V(6); PG8_BAR;
    for (;;) {
        const bool has_next = S.next(ui + 1, nxt);
        const char* nA = has_next ? (const char*)g.A + (size_t)nxt.pm * tstep : cA; const char* nB = has_next ? (const char*)g.Bt + (size_t)nxt.pn * tstep : cB;
        for (int t = 0; t < nt; t += 2) {
            const bool last = (t == nt - 2);
            const char* a1 = cA + (size_t)(t + 1) * kstep;
            const char* a2 = last ? nA : cA + (size_t)(t + 2) * kstep; const char* b2 = last ? nB : cB + (size_t)(t + 2) * kstep;
            const char* a3 = a2 + kstep; const char* b3 = b2 + kstep;
            PG8_LDB(B0, 0, 0); PG8_LDB(B1, 0, 1); PG8_SCHED; PG8_LDA(At, 0, 0); PG8_STAGE(PG8_SA(1, 1), a1 + hstep, voffA);
            PG8_WAIT_V(8); PG8_WAIT_L(0); PG8_BAR; PG8_MMA(0, 0, At, B0); PG8_MMA(0, 1, At, B1); PG8_BAR; PG8_SCHED;
            PG8_LDA(At, 0, 1); PG8_STAGE(PG8_SB(0, 0), b2, voffB); PG8_STAGE(PG8_SB(0, 1), b2 + hstep, voffB); PG8_STAGE(PG8_SA(0, 0), a2, voffA);
            PG8_WAIT_V(8); PG8_WAIT_L(0); PG8_BAR; PG8_MMA(1, 0, At, B0); PG8_MMA(1, 1, At, B1); PG8_BAR; PG8_SCHED;
            PG8_LDB(B0, 1, 0); PG8_LDB(B1, 1, 1); PG8_SCHED; PG8_LDA(At, 1, 0); PG8_STAGE(PG8_SA(0, 1), a2 + hstep, voffA);
            PG8_WAIT_V(8); PG8_WAIT_L(0); PG8_BAR; PG8_MMA(0, 0, At, B0); PG8_MMA(0, 1, At, B1); PG8_BAR; PG8_SCHED;
            PG8_LDA(At, 1, 1); PG8_STAGE(PG8_SB(1, 0), b3, voffB); PG8_STAGE(PG8_SB(1, 1), b3 + hstep, voffB); PG8_STAGE(PG8_SA(1, 0), a3, voffA);
            PG8_WAIT_V(8); PG8_WAIT_L(0); PG8_BAR; PG8_MMA(1, 0, At, B0); PG8_MMA(1, 1, At, B1); PG8_BAR; PG8_SCHED;
        }
        if (wr == 0) PG8_BAR;
        E(acc, cur, wr, wc, fr, fq);
        if (!has_next) break;
#pragma unroll
        for (int a = 0; a < 2; ++a)
#pragma unroll
            for (int b = 0; b < 2; ++b)
#pragma unroll
                for (int m = 0; m < 4; ++m)
#pragma unroll
                    for (int n = 0; n < 2; ++n) acc[a][b][m][n] = (f32x4){0.f, 0.f, 0.f, 0.f};
        cur = nxt; cA = nA; cB = nB; ++ui;
        if (wr == 1) PG8_BAR;
    }
    PG8_WAIT_V(0);
    PG8_BAR;
#undef PG8_SA
#undef PG8_SB
#undef PG8_STAGE
#undef PG8_LDA
#undef PG8_LDB
#undef PG8_MMA
#undef PG8_WAIT_V
#undef PG8_WAIT_L
#undef PG8_BAR
#undef PG8_SCHED
}
}

struct Params {
    const float* x; const float* ln_e; const float* w_in_e; const float* qkn_e; const float* lam_e; const float* subln_e; const float* w_out_e;
    const float* ln_o; const float* w_in_o; const float* qkn_o; const float* phi_pe; const float* phi_w1; const float* phi_w2; const float* w_out_o;
    float* out; unsigned char* ws;
    int ph_lo, ph_hi;
};

enum { OP_COPY = 0, OP_NORM = 1, OP_SILU = 2, OP_SIGM = 3 };
__device__ __forceinline__ void group_op(int layer, int G, const float* qkn, int& type, const float*& gain, float& scale) {
    type = OP_COPY; gain = qkn; scale = 1.f;
    if (layer == 0) {
        const int s = G >> 3;
        if (s == 0) { type = OP_NORM; gain = qkn; scale = C2; }
        else if (s == 1) { type = OP_NORM; gain = qkn + 64; }
        else if (s == 3 || s == 7) type = OP_SILU;
        else if (s == 4) { type = OP_NORM; gain = qkn + 128; scale = C2; }
        else if (s == 5) { type = OP_NORM; gain = qkn + 192; }
    } else {
        if (G < 8) { type = OP_NORM; gain = qkn; scale = C2; }
        else if (G < 16) { type = OP_NORM; gain = qkn + 64; }
        else if (G < 24) type = OP_COPY;
        else if (G < 32) type = OP_SILU;
        else if (G < 40) { type = OP_NORM; gain = qkn + 128; scale = C2; }
        else if (G < 44) type = OP_COPY;
        else if (G < 46) { type = OP_NORM; gain = qkn + 256; }
        else if (G < 48) type = OP_COPY;
        else if (G < 50) { type = OP_NORM; gain = qkn + 320; }
        else if (G < 52) type = OP_COPY;
        else if (G < 60) type = OP_SILU;
        else if (G == 60) type = OP_SIGM;
    }
}

struct EpiIn {
    static constexpr bool PERM = true;
    bf16_t* O; const float* ssq; const float* qkn; int layer;
    __device__ __forceinline__ void operator()(const f32x4 (&acc)[2][2][4][2], const pg8::Unit& u, int wr, int wc, int fr, int fq) const {
        int type; const float* gain; float scale; group_op(layer, u.pn * 4 + wc, qkn, type, gain, scale);
        f32x4 gv[2][2];
#pragma unroll
        for (int bj = 0; bj < 2; ++bj)
#pragma unroll
            for (int n = 0; n < 2; ++n) gv[bj][n] = (type == OP_NORM) ? *(const f32x4*)(gain + 32 * bj + 8 * fq + 4 * n) * scale : (f32x4){1.f, 1.f, 1.f, 1.f};
#pragma unroll
        for (int ai = 0; ai < 2; ++ai)
#pragma unroll
            for (int m = 0; m < 4; ++m) {
                const int row = u.pm * 256 + ai * 128 + wr * 64 + m * 16 + fr;
                const f32x4* sp = (const f32x4*)(ssq + (size_t)row * 16);
                const f32x4 s0 = sp[0], s1 = sp[1], s2 = sp[2], s3 = sp[3];
                const float tot = ((s0[0] + s0[1]) + (s0[2] + s0[3])) + ((s1[0] + s1[1]) + (s1[2] + s1[3])) + ((s2[0] + s2[1]) + (s2[2] + s2[3])) + ((s3[0] + s3[1]) + (s3[2] + s3[3]));
                const float rstd = __builtin_amdgcn_rsqf(tot * (1.0f / DM) + EPS);
                f32x4 v[2][2];
#pragma unroll
                for (int bj = 0; bj < 2; ++bj)
#pragma unroll
                    for (int n = 0; n < 2; ++n) v[bj][n] = acc[ai][bj][m][n] * rstd;
                if (type == OP_NORM) {
                    float ss = 0.f;
#pragma unroll
                    for (int bj = 0; bj < 2; ++bj)
#pragma unroll
                        for (int n = 0; n < 2; ++n) { const f32x4 t = v[bj][n]; ss += (t[0] * t[0] + t[1] * t[1]) + (t[2] * t[2] + t[3] * t[3]); }
                    ss += __shfl_xor(ss, 16); ss += __shfl_xor(ss, 32);
                    const float r = __builtin_amdgcn_rsqf(ss * (1.0f / 64.0f) + EPS);
#pragma unroll
                    for (int bj = 0; bj < 2; ++bj)
#pragma unroll
                        for (int n = 0; n < 2; ++n) v[bj][n] = v[bj][n] * r * gv[bj][n];
                } else if (type == OP_SILU || type == OP_SIGM) {
#pragma unroll
                    for (int bj = 0; bj < 2; ++bj)
#pragma unroll
                        for (int n = 0; n < 2; ++n)
#pragma unroll
                            for (int e = 0; e < 4; ++e) { const float t = v[bj][n][e]; const float sg = 1.0f / (1.0f + __builtin_amdgcn_exp2f(-t * LOG2E)); v[bj][n][e] = (type == OP_SILU) ? t * sg : sg; }
                }
                bf16_t* rowp = O + (size_t)row * PQ + u.pn * 256 + 64 * wc + 8 * fq;
#pragma unroll
                for (int bj = 0; bj < 2; ++bj) { u32x4 w; w.x = cvtpk(v[bj][0][0], v[bj][0][1]); w.y = cvtpk(v[bj][0][2], v[bj][0][3]); w.z = cvtpk(v[bj][1][0], v[bj][1][1]); w.w = cvtpk(v[bj][1][2], v[bj][1][3]);
                    *(u32x4*)(rowp + 32 * bj) = w; }
            }
    }
};

struct EpiOut {
    static constexpr bool PERM = false;
    const float* res; float* out; bf16_t* xn; float* ssq;
    __device__ __forceinline__ void operator()(const f32x4 (&acc)[2][2][4][2], const pg8::Unit& u, int wr, int wc, int fr, int fq) const {
#pragma unroll
        for (int ai = 0; ai < 2; ++ai)
#pragma unroll
            for (int m = 0; m < 4; ++m) {
                const int row = u.pm * 256 + ai * 128 + wr * 64 + m * 16 + fr; float ss = 0.f;
#pragma unroll
                for (int bj = 0; bj < 2; ++bj)
#pragma unroll
                    for (int n = 0; n < 2; ++n) {
                        const size_t off = (size_t)row * DM + u.pn * 256 + 128 * bj + 32 * wc + 16 * n + 4 * fq;
                        const f32x4 o = *(const f32x4*)(res + off) + acc[ai][bj][m][n];
                        *(f32x4*)(out + off) = o;
                        if (xn) { u32x2 w; w.x = cvtpk(o[0], o[1]); w.y = cvtpk(o[2], o[3]); *(u32x2*)(xn + off) = w; ss += (o[0] * o[0] + o[1] * o[1]) + (o[2] * o[2] + o[3] * o[3]); }
                    }
                if (xn) { ss += __shfl_xor(ss, 16); ss += __shfl_xor(ss, 32); if (fq == 0) ssq[(size_t)row * 16 + u.pn * 4 + wc] = ss; }
            }
    }
};

__device__ __forceinline__ int physrow(int L) { const int Lt = L & 255; return (L - Lt) + 128 * ((Lt >> 5) & 1) + 32 * (Lt >> 6) + (Lt & 31); }
__device__ __forceinline__ void transpose_item(const float* W, int K, int N, bf16_t* WT, bool permute, const float* g, LAS float* scr, int item, int lane, int nblk) {
    const int kb = item / nblk, nb = item % nblk, k0 = 64 * kb, n0 = 32 * nb;
    const int n = n0 + (lane & 31);
#pragma unroll 8
    for (int i = 0; i < 32; ++i) { const int kk = 2 * i + (lane >> 5); float v = (n < N) ? W[(size_t)(k0 + kk) * N + n] : 0.f; if (g) v *= g[k0 + kk]; scr[kk * 33 + (lane & 31)] = v; }
    LDS_WAIT();
    const int c = lane & 7; const int prow0 = permute ? physrow(n0) : n0;
#pragma unroll
    for (int j = 0; j < 4; ++j) { const int nn = (lane >> 3) + 8 * j; const LAS float* s = scr + (8 * c) * 33 + nn;
        u32x4 o; o.x = pk2(s[0 * 33], s[1 * 33]); o.y = pk2(s[2 * 33], s[3 * 33]); o.z = pk2(s[4 * 33], s[5 * 33]); o.w = pk2(s[6 * 33], s[7 * 33]);
        *(u32x4*)(WT + (size_t)(prow0 + nn) * K + k0 + 8 * c) = o; }
    LDS_WAIT();
}

__device__ __forceinline__ s16x4 vtr(const LAS char* p) { return __builtin_bit_cast(s16x4, __builtin_amdgcn_ds_read_tr16_b64_v4i16((LAS s16x4*)p)); }

__device__ __forceinline__ void qk_tile(f32x16& p0, f32x16& p1, const LAS char* Kt, const bf16x8 (&qr)[4], float cb, float stepk, int r32, int hi) {
    f32x16 c0, c1;
    const float cbh = cb + stepk * (float)(4 * hi), cbh1 = cbh + stepk * 32.f;
#pragma unroll
    for (int r = 0; r < 16; ++r) { c0[r] = cbh + stepk * (float)((r & 3) + 8 * (r >> 2)); c1[r] = cbh1 + stepk * (float)((r & 3) + 8 * (r >> 2)); }
    const LAS char* kb = Kt + hi * 1024 + r32 * 16;
#pragma unroll
    for (int d0 = 0; d0 < 4; ++d0) {
        const bf16x8 b0 = *(const LAS bf16x8*)(kb + d0 * 2048);
        const bf16x8 b1 = *(const LAS bf16x8*)(kb + d0 * 2048 + 512);
        if (d0 == 0) { p0 = __builtin_amdgcn_mfma_f32_32x32x16_bf16(b0, qr[0], c0, 0, 0, 0); p1 = __builtin_amdgcn_mfma_f32_32x32x16_bf16(b1, qr[0], c1, 0, 0, 0); }
        else { p0 = __builtin_amdgcn_mfma_f32_32x32x16_bf16(b0, qr[d0], p0, 0, 0, 0); p1 = __builtin_amdgcn_mfma_f32_32x32x16_bf16(b1, qr[d0], p1, 0, 0, 0); }
    }
}
__device__ __forceinline__ void mask_tile(f32x16& p0, f32x16& p1, int dq0, int pstride, int dmin, int dmaxe, int hi) {
    const float NEG = -INFINITY;
#pragma unroll
    for (int r = 0; r < 16; ++r) {
        const int d = dq0 - pstride * crow(r, hi), d1 = d - 32 * pstride;
        if (d < dmin || d > dmaxe) p0[r] = NEG;
        if (d1 < dmin || d1 > dmaxe) p1[r] = NEG;
    }
}
__device__ __forceinline__ float rowmax32(const f32x16& p0, const f32x16& p1) {
    float a = fmaxf(p0[0], p1[0]);
#pragma unroll
    for (int r = 1; r < 16; ++r) a = fmaxf(fmaxf(a, p0[r]), p1[r]);
    return swap_max(a);
}
__device__ __forceinline__ void pack_p(bf16x8 (&pw)[4], const f32x16& p0, const f32x16& p1) {
    u32x4 a, b, c, d;
    a.x = cvtpk(p0[0], p0[1]); a.y = cvtpk(p0[2], p0[3]); a.z = cvtpk(p0[4], p0[5]); a.w = cvtpk(p0[6], p0[7]);
    b.x = cvtpk(p0[8], p0[9]); b.y = cvtpk(p0[10], p0[11]); b.z = cvtpk(p0[12], p0[13]); b.w = cvtpk(p0[14], p0[15]);
    c.x = cvtpk(p1[0], p1[1]); c.y = cvtpk(p1[2], p1[3]); c.z = cvtpk(p1[4], p1[5]); c.w = cvtpk(p1[6], p1[7]);
    d.x = cvtpk(p1[8], p1[9]); d.y = cvtpk(p1[10], p1[11]); d.z = cvtpk(p1[12], p1[13]); d.w = cvtpk(p1[14], p1[15]);
    pw[0] = __builtin_bit_cast(bf16x8, a); pw[1] = __builtin_bit_cast(bf16x8, b); pw[2] = __builtin_bit_cast(bf16x8, c); pw[3] = __builtin_bit_cast(bf16x8, d);
}
template <int NDB>
__device__ __forceinline__ void pv_tile(f32x16 (&oT)[NDB], const LAS char* Vt, const bf16x8 (&pw)[4], int lane) {
    const int hi = lane >> 5;
    const LAS char* vb = Vt + ((lane >> 4) & 1) * 32 + (lane & 3) * 8 + (4 * hi + ((lane & 15) >> 2)) * 64;
#pragma unroll
    for (int db = 0; db < NDB; ++db)
#pragma unroll
        for (int ks = 0; ks < 4; ++ks) {
            const s16x4 lo = vtr(vb + db * 4096 + ks * 1024), hh = vtr(vb + db * 4096 + ks * 1024 + 512);
            const bf16x8 vf = (bf16x8){lo[0], lo[1], lo[2], lo[3], hh[0], hh[1], hh[2], hh[3]};
            oT[db] = __builtin_amdgcn_mfma_f32_32x32x16_bf16(vf, pw[ks], oT[db], 0, 0, 0);
            if (ks == 1 || ks == 3) __builtin_amdgcn_sched_barrier(0);
        }
}
template <int NDB>
__device__ __forceinline__ void attn_tile(const LAS char* Kt, const LAS char* Vt, const bf16x8 (&qr)[4], f32x16 (&oT)[NDB], float& mref, float& lsum,
                                          float cbase, float stepk, bool emask, int dq0, int pstride, int dmin, int dmaxe, int lane) {
    const int r32 = lane & 31, hi = lane >> 5;
    f32x16 p0, p1;
    qk_tile(p0, p1, Kt, qr, cbase - mref, stepk, r32, hi);
    if (emask) mask_tile(p0, p1, dq0, pstride, dmin, dmaxe, hi);
    const float mx = rowmax32(p0, p1);
    if (__any(mx > THR)) {
        const float d = fmaxf(mx, 0.f); mref += d;
#pragma unroll
        for (int r = 0; r < 16; ++r) { p0[r] -= d; p1[r] -= d; }
        const float a = __builtin_amdgcn_exp2f(-d); lsum *= a;
#pragma unroll
        for (int db = 0; db < NDB; ++db)
#pragma unroll
            for (int r = 0; r < 16; ++r) oT[db][r] *= a;
    }
    float s = 0.f;
#pragma unroll
    for (int r = 0; r < 16; ++r) { p0[r] = __builtin_amdgcn_exp2f(p0[r]); p1[r] = __builtin_amdgcn_exp2f(p1[r]); s += p0[r] + p1[r]; }
    lsum += s;
    bf16x8 pw[4]; pack_p(pw, p0, p1);
    pv_tile<NDB>(oT, Vt, pw, lane);
}

__device__ __forceinline__ void issue_k_piece(const bf16_t* colbase, size_t pitch, int tok_lane, LAS char* Kbuf, int piece) {
    glds16(colbase + (size_t)tok_lane * pitch + piece * 8, Kbuf + piece * 1024);
}
__device__ __forceinline__ void issue_v_piece(const bf16_t* colbase, size_t pitch, int tok_row, LAS char* Vbuf, int piece, int lane) {
    glds16(colbase + (size_t)tok_row * pitch + (piece >> 2) * 32 + (lane & 3) * 8, Vbuf + piece * 1024);
}
__device__ __forceinline__ int clampi(int v, int lo, int hi) { return v < lo ? lo : (v > hi ? hi : v); }

template <int NDB>
__device__ __forceinline__ void store_rows(const f32x16 (&o)[NDB], const bf16_t* zrow, bf16_t* orow, int hi) {
#pragma unroll
    for (int db = 0; db < NDB; ++db)
#pragma unroll
        for (int q4 = 0; q4 < 4; ++q4) {
            const int d = 32 * db + 8 * q4 + 4 * hi;
            const u32x2 zz = *(const u32x2*)(zrow + d);
            u32x2 w;
            w.x = cvtpk(o[db][4 * q4 + 0] * bf2f(zz.x & 0xffffu), o[db][4 * q4 + 1] * bf2f(zz.x >> 16));
            w.y = cvtpk(o[db][4 * q4 + 2] * bf2f(zz.y & 0xffffu), o[db][4 * q4 + 3] * bf2f(zz.y >> 16));
            *(u32x2*)(orow + d) = w;
            if (q4 == 3) asm volatile("" ::: "memory");
        }
}

__device__ __forceinline__ int next_unit(unsigned* ctr, LAS unsigned char* lds) {
    volatile LAS int* slot = (volatile LAS int*)(lds + LDSCTL_OFF);
    __syncthreads();
    if (threadIdx.x == 0) *slot = (int)atomicAdd(ctr, 1u);
    __syncthreads();
    return *slot;
}

__device__ __forceinline__ void unit_A(const Params& P, int u, LAS unsigned char* lds) {
    int tid_ = threadIdx.x; asm volatile("" : "+v"(tid_));
    const int tid = tid_, lane = tid & 63, w = __builtin_amdgcn_readfirstlane(tid >> 6), r32 = lane & 31, hi = lane >> 5;
    const int half = u & 1, span = (u >> 1) & 15, h = (u >> 5) & 7, b = u >> 8;
    const int ph = 8 * half + w, t0 = 512 * span;
    const int tq = t0 + ph + 16 * r32;
    const bf16_t* Q = (const bf16_t*)(P.ws + WS_QKV) + (size_t)b * SEQ * PQ;
    const bf16_t* qrow = Q + (size_t)tq * PQ + h * 64;
    bf16x8 qr[4];
#pragma unroll
    for (int d0 = 0; d0 < 4; ++d0) qr[d0] = *(const bf16x8*)(qrow + d0 * 16 + hi * 8);
    const float sl2 = __builtin_amdgcn_exp2f(-(float)(h + 1)) * LOG2E;
    f32x16 oT[2]; oT[0] = f32x16{}; oT[1] = f32x16{};
    float mref = 0.f, lsum = 0.f;
    LAS char* Kb = (LAS char*)lds + w * 16384; LAS char* Vb = Kb + 8192;
    const bf16_t* Kcol = Q + 512 + h * 64; const bf16_t* Vcol = Q + 1024 + h * 64;
#pragma unroll 1
    for (int pat = 0; pat < 3; ++pat) {
        const int pst = pat == 0 ? 1 : (pat == 1 ? 4 : 16), win = pat == 0 ? 128 : (pat == 1 ? 512 : 2048), ntile = pat == 0 ? 10 : (pat == 1 ? 4 : 3);
        const int pbase = pat == 0 ? (t0 - 128) : (t0 + ph - win);
        const float stepk = sl2 * (float)pst;
        const int dmaxe = win < tq ? win : tq;
#pragma unroll 1
        for (int k = 0; k < ntile; ++k) {
            const int p0 = pbase + 64 * pst * k, dq0 = tq - p0;
            const bool any_valid = __any((dq0 >= 0) && (dq0 - 63 * pst <= dmaxe));
            if (!any_valid) continue;
            LDS_WAIT();
            const int tokK = clampi(p0 + pst * lane, 0, SEQ - 1);
#pragma unroll
            for (int c = 0; c < 8; ++c) issue_k_piece(Kcol, PQ, tokK, Kb, c);
#pragma unroll
            for (int i = 0; i < 8; ++i) { const int tokV = clampi(p0 + pst * (16 * (i & 3) + (lane >> 2)), 0, SEQ - 1); issue_v_piece(Vcol, PQ, tokV, Vb, i, lane); }
            VM_WAIT();
            attn_tile<2>(Kb, Vb, qr, oT, mref, lsum, -sl2 * (float)dq0, stepk, true, dq0, pst, 0, dmaxe, lane);
        }
    }
    const float inv = 1.0f / swap_add(lsum);
#pragma unroll
    for (int db = 0; db < 2; ++db)
#pragma unroll
        for (int r = 0; r < 16; ++r) oT[db][r] *= inv;
    bf16_t* mixed = (bf16_t*)(P.ws + WS_MIXED) + ((size_t)b * SEQ + tq) * DM + h * 64;
    store_rows<2>(oT, Q + (size_t)tq * PQ + 1536 + h * 64, mixed, hi);
}

__device__ __forceinline__ void unit_B(const Params& P, int b, int h, int qb, LAS unsigned char* lds) {
    int tid_ = threadIdx.x; asm volatile("" : "+v"(tid_));
    const int tid = tid_, lane = tid & 63, w = __builtin_amdgcn_readfirstlane(tid >> 6), r32 = lane & 31, hi = lane >> 5;
    const int comp = w >> 2, qs = w & 3;
    const int tq = 128 * qb + 32 * qs + r32;
    const bf16_t* Q = (const bf16_t*)(P.ws + WS_QKV) + (size_t)b * SEQ * PQ;
    const bf16_t* qrow = Q + (size_t)tq * PQ + 2048 + h * 128 + comp * 64;
    bf16x8 qr[4];
#pragma unroll
    for (int d0 = 0; d0 < 4; ++d0) qr[d0] = *(const bf16x8*)(qrow + d0 * 16 + hi * 8);
    const float sl2 = __builtin_amdgcn_exp2f(-2.0f * (float)(h + 1)) * LOG2E;
    float lamv;
    { const float* lm = P.lam_e; const float a = lm[lane] * lm[64 + lane], c = lm[128 + lane] * lm[192 + lane];
      lamv = __expf(wave_sum(a)) - __expf(wave_sum(c)) + 0.2f; }
    f32x16 oT[4]; oT[0] = f32x16{}; oT[1] = f32x16{}; oT[2] = f32x16{}; oT[3] = f32x16{};
    float mref = 0.f, lsum = 0.f;
    const bf16_t* Kcol = Q + 2560 + h * 128; const bf16_t* Vcol = Q + 3072 + h * 128;
    const int NT = 2 * qb + 2;
    auto issue = [&](int kt, int s) {
        LAS char* Kb = (LAS char*)lds + s * 32768; LAS char* Vb = Kb + 16384;
        const int tk = 64 * kt + lane;
#pragma unroll
        for (int j = 0; j < 2; ++j) { const int pc = w + 8 * j; glds16(Kcol + (size_t)tk * PQ + (pc >> 3) * 64 + (pc & 7) * 8, Kb + pc * 1024); }
#pragma unroll
        for (int j = 0; j < 2; ++j) { const int pi = w + 8 * j; const int tv = 64 * kt + 16 * (pi & 3) + (lane >> 2); glds16(Vcol + (size_t)tv * PQ + (pi >> 2) * 32 + (lane & 3) * 8, Vb + pi * 1024); }
    };
    issue(NT - 1, 0);
#pragma unroll 1
    for (int it = 0; it < NT; ++it) {
        const int kt = NT - 1 - it;
        VM_WAIT(); __syncthreads();
        if (it + 1 < NT) issue(kt - 1, (it + 1) & 1);
        const LAS char* Kb = (const LAS char*)lds + (it & 1) * 32768 + comp * 8192; const LAS char* Vb = (const LAS char*)lds + (it & 1) * 32768 + 16384;
        const int dq0 = tq - 64 * kt;
        attn_tile<4>(Kb, Vb, qr, oT, mref, lsum, -sl2 * (float)dq0, sl2, kt >= 2 * qb, dq0, 1, 0, 1 << 30, lane);
    }
    LDS_WAIT(); __syncthreads();
    const float inv = 1.0f / swap_add(lsum);
    LAS float* scr = (LAS float*)lds + qs * 4096;
    if (comp == 1) {
        const float f = inv * lamv;
#pragma unroll
        for (int db = 0; db < 4; ++db)
#pragma unroll
            for (int r = 0; r < 16; ++r) scr[(db * 16 + r) * 64 + lane] = oT[db][r] * f;
    }
    LDS_WAIT(); __syncthreads();
    if (comp == 0) {
        float ss = 0.f;
#pragma unroll
        for (int db = 0; db < 4; ++db) {
#pragma unroll
            for (int r = 0; r < 16; ++r) { const float v = oT[db][r] * inv - scr[(db * 16 + r) * 64 + lane]; oT[db][r] = v; ss += v * v; }
            asm volatile("" ::: "memory");
        }
        ss = swap_add(ss);
        const float rr = __builtin_amdgcn_rsqf(ss * (1.0f / 128.0f) + EPS) * 0.8f;
        const float* sg = P.subln_e;
#pragma unroll
        for (int db = 0; db < 4; ++db) {
#pragma unroll
            for (int q4 = 0; q4 < 4; ++q4) { const f32x4 gq = *(const f32x4*)(sg + 32 * db + 8 * q4 + 4 * hi);
#pragma unroll
                for (int e = 0; e < 4; ++e) oT[db][4 * q4 + e] *= rr * gq[e]; }
            asm volatile("" ::: "memory");
        }
        bf16_t* mixed = (bf16_t*)(P.ws + WS_MIXED) + ((size_t)b * SEQ + tq) * DM + 512 + h * 128;
        store_rows<4>(oT, Q + (size_t)tq * PQ + 3584 + h * 128, mixed, hi);
    }
    LDS_WAIT();
}

__device__ __forceinline__ bool better(float av, int an, float bv, int bn) { return av > bv || (av == bv && an < bn); }
__device__ __forceinline__ void unit_C(const Params& P, int b, int h, int i, LAS unsigned char* lds) {
    int tid_ = threadIdx.x; asm volatile("" : "+v"(tid_));
    const int tid = tid_, lane = tid & 63, w = __builtin_amdgcn_readfirstlane(tid >> 6), r32 = lane & 31, hi = lane >> 5;
    const int tq = 256 * i + 32 * w + r32;
    const bf16_t* Q = (const bf16_t*)(P.ws + WS_QKV) + (size_t)b * SEQ * PQ;
    const bf16_t* qrow = Q + (size_t)tq * PQ + h * 64;
    bf16x8 qr[4];
#pragma unroll
    for (int d0 = 0; d0 < 4; ++d0) qr[d0] = *(const bf16x8*)(qrow + d0 * 16 + hi * 8);
    unsigned sel = 0u;
    if (i > 0) {
        const float* km = (const float*)(P.ws + WS_KMEAN) + (size_t)(b * 8 + h) * 32 * 64;
        LAS char* Th = (LAS char*)lds + 65536; LAS char* Tl = Th + 8192;
#pragma unroll
        for (int j = 0; j < 4; ++j) { const int idx = tid * 4 + j, n = idx >> 6, d = idx & 63; const float v = km[idx];
            const unsigned hb = f2bf(v); const unsigned lb = f2bf(v - bf2f(hb)); const int off = (d >> 3) * 1024 + n * 16 + (d & 7) * 2;
            *(LAS bf16_t*)(Th + off) = (bf16_t)hb; *(LAS bf16_t*)(Tl + off) = (bf16_t)lb; }
        LDS_WAIT(); __syncthreads();
        f32x16 g = f32x16{};
        const LAS char* kh = Th + hi * 1024 + r32 * 16; const LAS char* kl = Tl + hi * 1024 + r32 * 16;
#pragma unroll
        for (int d0 = 0; d0 < 4; ++d0) { g = __builtin_amdgcn_mfma_f32_32x32x16_bf16(*(const LAS bf16x8*)(kh + d0 * 2048), qr[d0], g, 0, 0, 0);
                                         g = __builtin_amdgcn_mfma_f32_32x32x16_bf16(*(const LAS bf16x8*)(kl + d0 * 2048), qr[d0], g, 0, 0, 0); }
        float v1 = -INFINITY, v2 = -INFINITY, v3 = -INFINITY; int n1 = 99, n2 = 99, n3 = 99;
#pragma unroll
        for (int r = 0; r < 16; ++r) { const int n = crow(r, hi); const float v = (n < i) ? g[r] : -INFINITY;
            if (v > v1) { v3 = v2; n3 = n2; v2 = v1; n2 = n1; v1 = v; n1 = n; }
            else if (v > v2) { v3 = v2; n3 = n2; v2 = v; n2 = n; }
            else if (v > v3) { v3 = v; n3 = n; } }
        float pv[3] = {__shfl_xor(v1, 32), __shfl_xor(v2, 32), __shfl_xor(v3, 32)}; int pn[3] = {__shfl_xor(n1, 32), __shfl_xor(n2, 32), __shfl_xor(n3, 32)};
#pragma unroll
        for (int k = 0; k < 3; ++k) { const float v = pv[k]; const int n = pn[k];
            if (better(v, n, v1, n1)) { v3 = v2; n3 = n2; v2 = v1; n2 = n1; v1 = v; n1 = n; }
            else if (better(v, n, v2, n2)) { v3 = v2; n3 = n2; v2 = v; n2 = n; }
            else if (better(v, n, v3, n3)) { v3 = v; n3 = n; } }
        if (v1 > -INFINITY) sel |= 1u << n1; if (v2 > -INFINITY) sel |= 1u << n2; if (v3 > -INFINITY) sel |= 1u << n3;
    }
    const float sl2 = __builtin_amdgcn_exp2f(-(float)(h + 1)) * LOG2E;
    f32x16 oT[2]; oT[0] = f32x16{}; oT[1] = f32x16{};
    float mref = 0.f, lsum = 0.f;
    const bf16_t* Kcol = Q + 512 + h * 64; const bf16_t* Vcol = Q + 1024 + h * 64;
    const int NT = 4 * i + 4;
    auto issue = [&](int kt, int s) {
        LAS char* Kb = (LAS char*)lds + s * 16384; LAS char* Vb = Kb + 8192;
        issue_k_piece(Kcol, PQ, 64 * kt + lane, Kb, w);
        issue_v_piece(Vcol, PQ, 64 * kt + 16 * (w & 3) + (lane >> 2), Vb, w, lane);
    };
    issue(NT - 1, 0);
#pragma unroll 1
    for (int it = 0; it < NT; ++it) {
        const int kt = NT - 1 - it;
        VM_WAIT(); __syncthreads();
        if (it + 1 < NT) issue(kt - 1, (it + 1) & 1);
        const LAS char* Kb = (const LAS char*)lds + (it & 1) * 16384; const LAS char* Vb = Kb + 8192;
        const int dq0 = tq - 64 * kt; const bool own = kt >= 4 * i;
        const bool on = own || ((sel >> (kt >> 2)) & 1u);
        if (!__any(on)) continue;
        attn_tile<2>(Kb, Vb, qr, oT, mref, lsum, on ? -sl2 * (float)dq0 : -INFINITY, sl2, own, dq0, 1, 0, 1 << 30, lane);
    }
    const float inv = 1.0f / swap_add(lsum);
#pragma unroll
    for (int db = 0; db < 2; ++db)
#pragma unroll
        for (int r = 0; r < 16; ++r) oT[db][r] *= inv;
    bf16_t* mixed = (bf16_t*)(P.ws + WS_MIXED) + ((size_t)b * SEQ + tq) * DM + h * 64;
    store_rows<2>(oT, Q + (size_t)tq * PQ + 1536 + h * 64, mixed, hi);
    LDS_WAIT();
}

constexpr int IMP_PITCH = 132;
__device__ __forceinline__ unsigned dpp_max_u32_8(unsigned v) {
    unsigned t;
    t = (unsigned)__builtin_amdgcn_update_dpp(0, (int)v, 0xB1, 0xF, 0xF, true); v = v > t ? v : t;
    t = (unsigned)__builtin_amdgcn_update_dpp(0, (int)v, 0x4E, 0xF, 0xF, true); v = v > t ? v : t;
    t = (unsigned)__builtin_amdgcn_update_dpp(0, (int)v, 0x141, 0xF, 0xF, true); v = v > t ? v : t;
    return v;
}
__device__ __forceinline__ void unit_D(const Params& P, int b, int hkv, int qt, LAS unsigned char* lds) {
    int tid_ = threadIdx.x; asm volatile("" : "+v"(tid_));
    const int tid = tid_, lane = tid & 63, w = __builtin_amdgcn_readfirstlane(tid >> 6), r32 = lane & 31, hi = lane >> 5;
    const int qi = r32 & 7, g = r32 >> 3, hq = 4 * hkv + g;
    const int ql = 8 * w + qi, tq = 64 * qt + ql;
    const bf16_t* Q = (const bf16_t*)(P.ws + WS_QKV) + (size_t)b * SEQ * PQ;
    const bf16_t* qrow = Q + (size_t)tq * PQ + 2048 + hq * 64;
    bf16x8 qr[4];
#pragma unroll
    for (int d0 = 0; d0 < 4; ++d0) qr[d0] = *(const bf16x8*)(qrow + d0 * 16 + hi * 8);
    const float sl2 = __builtin_amdgcn_exp2f(-(float)(hq + 1)) * LOG2E;
    LAS float* imp = (LAS float*)(lds + 32768);
    LAS unsigned short* selm = (LAS unsigned short*)(lds + 67584);
    LAS unsigned* uni = (LAS unsigned*)(lds + 68608);
    for (int k = tid; k < 64 * IMP_PITCH; k += NTHREADS) imp[k] = 0.f;
    if (tid < 4) uni[tid] = 0u;
    LAS float* stash = (LAS float*)(lds + 69632) + w * 2048 + lane;
    const bf16_t* gp = Q + (size_t)tq * PQ + 3840 + 3 * hq;

#ifndef D_NOCMP
    {
        const bf16_t* Kc = (const bf16_t*)(P.ws + WS_KCMP) + (size_t)(b * 2 + hkv) * 512 * 64;
        const bf16_t* Vc = (const bf16_t*)(P.ws + WS_VCMP) + (size_t)(b * 2 + hkv) * 512 * 64;
        const int NTc = (4 * qt + 2) / 64 + 1;
        const float stepk = sl2 * 16.f;
        auto issue = [&](int ti, int s, bool withv) {
            LAS char* Kb = (LAS char*)lds + s * 16384; LAS char* Vb = Kb + 8192;
            issue_k_piece(Kc, 64, 64 * ti + lane, Kb, w);
            if (withv) issue_v_piece(Vc, 64, 64 * ti + 16 * (w & 3) + (lane >> 2), Vb, w, lane);
        };
        float mref = 0.f, lsum = 0.f;
        issue(0, 0, false);
#pragma unroll 1
        for (int ti = 0; ti < NTc; ++ti) {
            VM_WAIT(); __syncthreads();
            if (ti + 1 < NTc) issue(ti + 1, (ti + 1) & 1, false);
            const LAS char* Kb = (const LAS char*)lds + (ti & 1) * 16384;
            const int dq0 = tq - (1024 * ti + 31);
            f32x16 p0, p1;
            qk_tile(p0, p1, Kb, qr, -sl2 * (float)dq0 - mref, stepk, r32, hi);
            mask_tile(p0, p1, dq0, 16, 0, 1 << 30, hi);
            const float mx = rowmax32(p0, p1);
            if (__any(mx > THR)) { const float d = fmaxf(mx, 0.f); mref += d;
#pragma unroll
                for (int r = 0; r < 16; ++r) { p0[r] -= d; p1[r] -= d; }
                lsum *= __builtin_amdgcn_exp2f(-d); }
            float s = 0.f;
#pragma unroll
            for (int r = 0; r < 16; ++r) s += __builtin_amdgcn_exp2f(p0[r]) + __builtin_amdgcn_exp2f(p1[r]);
            lsum += s;
        }
        const float ltot = swap_add(lsum);
        const float linv = ltot > 0.f ? 1.0f / ltot : 0.f;
        __syncthreads();
        f32x16 oT[2]; oT[0] = f32x16{}; oT[1] = f32x16{};
        issue(0, 0, true);
#pragma unroll 1
        for (int ti = 0; ti < NTc; ++ti) {
            VM_WAIT(); __syncthreads();
            if (ti + 1 < NTc) issue(ti + 1, (ti + 1) & 1, true);
            const LAS char* Kb = (const LAS char*)lds + (ti & 1) * 16384; const LAS char* Vb = Kb + 8192;
            const int dq0 = tq - (1024 * ti + 31);
            f32x16 p0, p1;
            qk_tile(p0, p1, Kb, qr, -sl2 * (float)dq0 - mref, stepk, r32, hi);
            mask_tile(p0, p1, dq0, 16, 0, 1 << 30, hi);
#pragma unroll
            for (int r = 0; r < 16; ++r) { p0[r] = __builtin_amdgcn_exp2f(p0[r]) * linv; p1[r] = __builtin_amdgcn_exp2f(p1[r]) * linv; }
#pragma unroll
            for (int hf = 0; hf < 2; ++hf)
#pragma unroll
                for (int c = 0; c < 4; ++c) {
                    const f32x16& pp = hf ? p1 : p0;
                    float G = (pp[4 * c] + pp[4 * c + 1]) + (pp[4 * c + 2] + pp[4 * c + 3]); float L = pp[4 * c + 3];
                    G += __shfl_xor(G, 8); G += __shfl_xor(G, 16); L += __shfl_xor(L, 8); L += __shfl_xor(L, 16);
                    const int j = 16 * ti + 8 * hf + 2 * c + hi;
                    if (g == 0) { LAS float* ip = imp + ql * IMP_PITCH + j; ip[0] += G; }
                    LDS_WAIT();
                    if (g == 0) { LAS float* ip = imp + ql * IMP_PITCH + j + 1; ip[0] += L; }
                    LDS_WAIT();
                }
            bf16x8 pw[4]; pack_p(pw, p0, p1);
            pv_tile<2>(oT, Vb, pw, lane);
        }
        const float g0 = bf2f(gp[0]);
#pragma unroll
        for (int db = 0; db < 2; ++db)
#pragma unroll
            for (int r = 0; r < 16; ++r) stash[(db * 16 + r) * 64] = g0 * oT[db][r];
    }
#endif
    LDS_WAIT(); __syncthreads();
#ifndef D_NOTOPK
    {
        const int qq = 8 * w + (lane >> 3), sub = lane & 7;
        unsigned key[16];
#pragma unroll
        for (int k = 0; k < 16; ++k) { const int j = 16 * sub + k; const float v = imp[qq * IMP_PITCH + j];
            unsigned kk = ((__float_as_uint(v) >> 7) << 7) + (unsigned)(128 - j);
            if (j == 0 || j == qt || j == qt - 1) kk = 0xFFFFFF00u | (unsigned)(128 - j);
            if (j > qt) kk = 0u;
            key[k] = kk; }
        unsigned selb = 0u;
#pragma unroll 1
        for (int round = 0; round < 16; ++round) {
            unsigned lm = key[0];
#pragma unroll
            for (int k = 1; k < 16; ++k) lm = key[k] > lm ? key[k] : lm;
            const unsigned gm = dpp_max_u32_8(lm);
            if (gm != 0u) {
#pragma unroll
                for (int k = 0; k < 16; ++k) { const bool hit = key[k] == gm; selb |= hit ? (1u << k) : 0u; key[k] = hit ? 0u : key[k]; }
            }
        }
        selm[qq * 8 + sub] = (unsigned short)selb;
    }
#endif
    LDS_WAIT(); __syncthreads();
    unsigned msk[4];
    { const LAS unsigned* mp = (const LAS unsigned*)(selm + ql * 8); msk[0] = mp[0]; msk[1] = mp[1]; msk[2] = mp[2]; msk[3] = mp[3]; }
    {
        unsigned o0 = msk[0], o1 = msk[1], o2 = msk[2], o3 = msk[3];
#pragma unroll
        for (int s = 1; s < 8; s <<= 1) { o0 |= __shfl_xor(o0, s); o1 |= __shfl_xor(o1, s); o2 |= __shfl_xor(o2, s); o3 |= __shfl_xor(o3, s); }
        if (lane == 0) { atomicOr((unsigned*)&uni[0], o0); atomicOr((unsigned*)&uni[1], o1); atomicOr((unsigned*)&uni[2], o2); atomicOr((unsigned*)&uni[3], o3); }
    }
    LDS_WAIT(); __syncthreads();
    unsigned um[4] = {uni[0], uni[1], uni[2], uni[3]};
    um[0] = __builtin_amdgcn_readfirstlane(um[0]); um[1] = __builtin_amdgcn_readfirstlane(um[1]); um[2] = __builtin_amdgcn_readfirstlane(um[2]); um[3] = __builtin_amdgcn_readfirstlane(um[3]);
#ifndef D_NOSLC
    {
        const bf16_t* Kcol = Q + 2816 + hkv * 64; const bf16_t* Vcol = Q + 2944 + hkv * 64;
        auto nextblk = [&](int below) -> int {
            for (int wd = 3; wd >= 0; --wd) { unsigned m = um[wd]; const int lim = below - 32 * wd; if (lim <= 0) continue; if (lim < 32) m &= (1u << lim) - 1u; if (m) return 32 * wd + 31 - __builtin_clz(m); }
            return -1;
        };
        auto issue = [&](int j, int s) {
            LAS char* Kb = (LAS char*)lds + s * 16384; LAS char* Vb = Kb + 8192;
            issue_k_piece(Kcol, PQ, 64 * j + lane, Kb, w);
            issue_v_piece(Vcol, PQ, 64 * j + 16 * (w & 3) + (lane >> 2), Vb, w, lane);
        };
        f32x16 oT[2]; oT[0] = f32x16{}; oT[1] = f32x16{};
        float mref = 0.f, lsum = 0.f;
        int j = nextblk(128), it = 0;
        if (j >= 0) issue(j, 0);
#pragma unroll 1
        while (j >= 0) {
            const int jn = nextblk(j);
            VM_WAIT(); __syncthreads();
            if (jn >= 0) issue(jn, (it + 1) & 1);
            const LAS char* Kb = (const LAS char*)lds + (it & 1) * 16384; const LAS char* Vb = Kb + 8192;
            const int dq0 = tq - 64 * j;
            const unsigned mw = j < 32 ? msk[0] : (j < 64 ? msk[1] : (j < 96 ? msk[2] : msk[3]));
            const bool on = (mw >> (j & 31)) & 1u;
            if (__any(on))
                attn_tile<2>(Kb, Vb, qr, oT, mref, lsum, on ? -sl2 * (float)dq0 : -INFINITY, sl2, j == qt, dq0, 1, 0, 1 << 30, lane);
            j = jn; ++it;
        }
        const float f = bf2f(gp[1]) / swap_add(lsum);
#pragma unroll
        for (int db = 0; db < 2; ++db)
#pragma unroll
            for (int r = 0; r < 16; ++r) stash[(db * 16 + r) * 64] += f * oT[db][r];
    }
#endif
    __syncthreads();
#ifndef D_NOWIN
    {
        const bf16_t* Kcol = Q + 3072 + hkv * 64; const bf16_t* Vcol = Q + 3200 + hkv * 64;
        auto issue = [&](int kt, int s) {
            LAS char* Kb = (LAS char*)lds + s * 16384; LAS char* Vb = Kb + 8192;
            issue_k_piece(Kcol, PQ, 64 * kt + lane, Kb, w);
            issue_v_piece(Vcol, PQ, 64 * kt + 16 * (w & 3) + (lane >> 2), Vb, w, lane);
        };
        f32x16 oT[2]; oT[0] = f32x16{}; oT[1] = f32x16{};
        float mref = 0.f, lsum = 0.f;
        const int klo = qt - 8 > 0 ? qt - 8 : 0, NT = qt - klo + 1;
        issue(qt, 0);
#pragma unroll 1
        for (int it = 0; it < NT; ++it) {
            const int kt = qt - it;
            VM_WAIT(); __syncthreads();
            if (it + 1 < NT) issue(kt - 1, (it + 1) & 1);
            const LAS char* Kb = (const LAS char*)lds + (it & 1) * 16384; const LAS char* Vb = Kb + 8192;
            const int dq0 = tq - 64 * kt;
            attn_tile<2>(Kb, Vb, qr, oT, mref, lsum, -sl2 * (float)dq0, sl2, (kt == qt) || (kt == qt - 8), dq0, 1, 0, 511, lane);
        }
        const float f = bf2f(gp[2]) / swap_add(lsum);
#pragma unroll
        for (int db = 0; db < 2; ++db)
#pragma unroll
            for (int r = 0; r < 16; ++r) oT[db][r] = stash[(db * 16 + r) * 64] + f * oT[db][r];
        bf16_t* mixed = (bf16_t*)(P.ws + WS_MIXED) + ((size_t)b * SEQ + tq) * DM + 512 + hq * 64;
        store_rows<2>(oT, Q + (size_t)tq * PQ + 3328 + hq * 64, mixed, hi);
    }
#endif
    LDS_WAIT();
}

__device__ __forceinline__ void kmean_unit(const Params& P, int u, int lane) {
    const int blk = u & 31, h = (u >> 5) & 7, b = u >> 8;
    const bf16_t* K = (const bf16_t*)(P.ws + WS_QKV) + ((size_t)b * SEQ + 256 * blk) * PQ + 512 + h * 64;
    float a[8] = {0.f, 0.f, 0.f, 0.f, 0.f, 0.f, 0.f, 0.f};
    const int c = lane & 7, rs = lane >> 3;
#pragma unroll 4
    for (int it = 0; it < 32; ++it) { const u32x4 v = *(const u32x4*)(K + (size_t)(8 * it + rs) * PQ + 8 * c);
        a[0] += bf2f(v.x & 0xffffu); a[1] += bf2f(v.x >> 16); a[2] += bf2f(v.y & 0xffffu); a[3] += bf2f(v.y >> 16);
        a[4] += bf2f(v.z & 0xffffu); a[5] += bf2f(v.z >> 16); a[6] += bf2f(v.w & 0xffffu); a[7] += bf2f(v.w >> 16); }
#pragma unroll
    for (int k = 0; k < 8; ++k) { float s = a[k]; s += __shfl_xor(s, 8); s += __shfl_xor(s, 16); s += __shfl_xor(s, 32); a[k] = s * (1.0f / 256.0f); }
    if (rs == 0) { float* o = (float*)(P.ws + WS_KMEAN) + (size_t)u * 64 + 8 * c;
        *(f32x4*)o = (f32x4){a[0], a[1], a[2], a[3]}; *(f32x4*)(o + 4) = (f32x4){a[4], a[5], a[6], a[7]}; }
}
__device__ __forceinline__ void compress_unit(const Params& P, int u, int lane) {
    const int chunk = u & 15, hkv = (u >> 4) & 1, b = (u >> 5) & 3, which = u >> 7;
    const int r32 = lane & 31, hi = lane >> 5;
    const int n = 32 * chunk + r32, nc = n > 510 ? 510 : n;
    const bf16_t* X = (const bf16_t*)(P.ws + WS_QKV) + ((size_t)b * SEQ + 16 * nc) * PQ + (which ? 2688 : 2560) + hkv * 64 + 8 * hi;
    const bf16_t* W1 = (const bf16_t*)(P.ws + WS_W1T) + (size_t)which * 128 * 2048 + (size_t)r32 * 2048 + 8 * hi;
    f32x16 hT[4]; hT[0] = f32x16{}; hT[1] = f32x16{}; hT[2] = f32x16{}; hT[3] = f32x16{};
#pragma unroll 4
    for (int ks = 0; ks < 128; ++ks) {
        const bf16x8 xb = *(const bf16x8*)(X + (size_t)(ks >> 2) * PQ + (ks & 3) * 16);
#pragma unroll
        for (int cb = 0; cb < 4; ++cb) { const bf16x8 wa = *(const bf16x8*)(W1 + (size_t)cb * 32 * 2048 + ks * 16);
            hT[cb] = __builtin_amdgcn_mfma_f32_32x32x16_bf16(wa, xb, hT[cb], 0, 0, 0); }
    }
    const float* b1 = (const float*)(P.ws + WS_BIAS1) + which * 128;
    const bf16_t* W2 = (const bf16_t*)(P.ws + WS_W2T) + (size_t)which * 64 * 128;
    f32x16 oT[2]; oT[0] = f32x16{}; oT[1] = f32x16{};
#pragma unroll
    for (int cb = 0; cb < 4; ++cb) {
#pragma unroll
        for (int r = 0; r < 16; ++r) { const float t = hT[cb][r] + b1[32 * cb + crow(r, hi)]; hT[cb][r] = t / (1.0f + __builtin_amdgcn_exp2f(-t * LOG2E)); }
#pragma unroll
        for (int s = 0; s < 2; ++s) {
            u32x4 pb; pb.x = cvtpk(hT[cb][8 * s + 0], hT[cb][8 * s + 1]); pb.y = cvtpk(hT[cb][8 * s + 2], hT[cb][8 * s + 3]); pb.z = cvtpk(hT[cb][8 * s + 4], hT[cb][8 * s + 5]); pb.w = cvtpk(hT[cb][8 * s + 6], hT[cb][8 * s + 7]);
            const bf16x8 bfrag = __builtin_bit_cast(bf16x8, pb);
#pragma unroll
            for (int ob = 0; ob < 2; ++ob) { const bf16_t* wp = W2 + (size_t)(32 * ob + r32) * 128 + 32 * cb + 16 * s + 4 * hi;
                const u32x2 a0 = *(const u32x2*)wp, a1 = *(const u32x2*)(wp + 8);
                const bf16x8 afrag = __builtin_bit_cast(bf16x8, (u32x4){a0.x, a0.y, a1.x, a1.y});
                oT[ob] = __builtin_amdgcn_mfma_f32_32x32x16_bf16(afrag, bfrag, oT[ob], 0, 0, 0); }
        }
    }
    if (which == 0) {
        float ss = 0.f;
#pragma unroll
        for (int ob = 0; ob < 2; ++ob)
#pragma unroll
            for (int r = 0; r < 16; ++r) ss += oT[ob][r] * oT[ob][r];
        ss = swap_add(ss);
        const float rr = __builtin_amdgcn_rsqf(ss * (1.0f / 64.0f) + EPS); const float* gn = P.qkn_o + 192;
#pragma unroll
        for (int ob = 0; ob < 2; ++ob)
#pragma unroll
            for (int r = 0; r < 16; ++r) oT[ob][r] *= rr * gn[32 * ob + crow(r, hi)];
    }
    bf16_t* orow = (bf16_t*)(P.ws + (which ? WS_VCMP : WS_KCMP)) + ((size_t)(b * 2 + hkv) * 512 + n) * 64;
#pragma unroll
    for (int ob = 0; ob < 2; ++ob)
#pragma unroll
        for (int q4 = 0; q4 < 4; ++q4) { u32x2 wv; wv.x = cvtpk(oT[ob][4 * q4], oT[ob][4 * q4 + 1]); wv.y = cvtpk(oT[ob][4 * q4 + 2], oT[ob][4 * q4 + 3]);
            *(u32x2*)(orow + 32 * ob + 8 * q4 + 4 * hi) = wv; }
}

__global__ void __launch_bounds__(NTHREADS, 2) mk_fwd(Params P) {
    extern __shared__ __attribute__((aligned(16))) unsigned char lds_raw[];
    LAS unsigned char* lds = (LAS unsigned char*)lds_raw;
    const int tid = threadIdx.x, lane = tid & 63, wave = __builtin_amdgcn_readfirstlane(tid >> 6);
    const int G = gridDim.x;
    const int gw = blockIdx.x * NWAVES + wave, NGW = G * NWAVES;
    unsigned* ctl = (unsigned*)(P.ws + WS_CTL);
    bf16_t* Wt_in_e = (bf16_t*)(P.ws + WS_WIN_E); bf16_t* Wt_out_e = (bf16_t*)(P.ws + WS_WOUT_E);
    bf16_t* Wt_in_o = (bf16_t*)(P.ws + WS_WIN_O); bf16_t* Wt_out_o = (bf16_t*)(P.ws + WS_WOUT_O);
    bf16_t* XN = (bf16_t*)(P.ws + WS_XN); bf16_t* MIXED = (bf16_t*)(P.ws + WS_MIXED); bf16_t* QKV = (bf16_t*)(P.ws + WS_QKV);
    float* SSQ0 = (float*)(P.ws + WS_SSQ0); float* SSQ1 = (float*)(P.ws + WS_SSQ1);
#if MK_LAUNCHES == 1
    cg::grid_group grid = cg::this_grid();
#define SEAM(k) do { if (P.ph_lo <= (k) && (k) + 1 < P.ph_hi) grid.sync(); } while (0)
#else
#define SEAM(k) do { } while (0)
#endif
#define IN(k) (P.ph_lo <= (k) && (k) < P.ph_hi)

    if (IN(0)) {
        LAS float* scr = (LAS float*)(lds + wave * 16384);
        constexpr int I_IN = 16 * 128, I_OUT = 16 * 32, I_W1 = 32 * 4, I_W2 = 2 * 2;
        constexpr int NIT = 2 * I_IN + 2 * I_OUT + 2 * I_W1 + 2 * I_W2;
        for (int it = gw; it < NIT; it += NGW) {
            int r = it;
            if (r < I_IN) { transpose_item(P.w_in_e, DM, 4096, Wt_in_e, true, P.ln_e, scr, r, lane, 128); continue; } r -= I_IN;
            if (r < I_IN) { transpose_item(P.w_in_o, DM, ODD_N, Wt_in_o, true, P.ln_o, scr, r, lane, 128); continue; } r -= I_IN;
            if (r < I_OUT) { transpose_item(P.w_out_e, DM, DM, Wt_out_e, false, nullptr, scr, r, lane, 32); continue; } r -= I_OUT;
            if (r < I_OUT) { transpose_item(P.w_out_o, DM, DM, Wt_out_o, false, nullptr, scr, r, lane, 32); continue; } r -= I_OUT;
            if (r < 2 * I_W1) { const int wh = r / I_W1; transpose_item(P.phi_w1 + (size_t)wh * 2048 * 128, 2048, 128, (bf16_t*)(P.ws + WS_W1T) + (size_t)wh * 128 * 2048, false, nullptr, scr, r % I_W1, lane, 4); continue; } r -= 2 * I_W1;
            { const int wh = r / I_W2; transpose_item(P.phi_w2 + (size_t)wh * 128 * 64, 128, 64, (bf16_t*)(P.ws + WS_W2T) + (size_t)wh * 64 * 128, false, nullptr, scr, r % I_W2, lane, 2); }
        }
        for (int it = gw; it < 256; it += NGW) { const int wh = it >> 7, c = it & 127; const float* pe = P.phi_pe + (size_t)wh * 2048; const float* w1 = P.phi_w1 + (size_t)wh * 2048 * 128;
            float s = 0.f; for (int k = lane; k < 2048; k += 64) s += pe[k] * w1[(size_t)k * 128 + c]; s = wave_sum(s);
            if (lane == 0) ((float*)(P.ws + WS_BIAS1))[it] = s; }
        for (int m = gw; m < MTOK; m += NGW) {
            const f32x4* xr = (const f32x4*)(P.x + (size_t)m * DM) + lane; f32x4 v[4]; float s = 0.f;
#pragma unroll
            for (int j = 0; j < 4; ++j) { v[j] = xr[64 * j]; s += (v[j][0] * v[j][0] + v[j][1] * v[j][1]) + (v[j][2] * v[j][2] + v[j][3] * v[j][3]); }
            s = wave_sum(s);
            u32x2* o8 = (u32x2*)(XN + (size_t)m * DM) + lane;
#pragma unroll
            for (int j = 0; j < 4; ++j) { u32x2 wv; wv.x = cvtpk(v[j][0], v[j][1]); wv.y = cvtpk(v[j][2], v[j][3]); o8[64 * j] = wv; }
            if (lane < 16) SSQ0[(size_t)m * 16 + lane] = lane == 0 ? s : 0.f;
        }
    }
    SEAM(0);
    if (IN(1)) {
        pg8::Gemm g{XN, Wt_in_e, MTOK, 4096, DM}; pg8::StaticOrder S; S.init(MTOK, 4096, G, (int)blockIdx.x);
        EpiIn E{QKV, SSQ0, P.qkn_e, 0};
        pg8::gemm_phase<EpiIn>(lds, g, S, E);
    }
    SEAM(1);
    if (IN(2)) {
        for (;;) {
            const int u = next_unit(ctl + 64, lds);
            if (u >= 2048) break;
            if (u < 928) { if (EN_B) unit_B(P, (u & 15) >> 2, u & 3, 63 - (u >> 4), lds); }
            else if (u < 1952) { if (EN_A) unit_A(P, u - 928, lds); }
            else { const int v = u - 1952; if (EN_B) unit_B(P, (v & 15) >> 2, v & 3, 5 - (v >> 4), lds); }
        }
    }
    SEAM(2);
    if (IN(3)) {
        pg8::Gemm g{MIXED, Wt_out_e, MTOK, DM, DM}; pg8::StaticOrder S; S.init(MTOK, DM, G, (int)blockIdx.x);
        EpiOut E{P.x, P.out, XN, SSQ1};
        pg8::gemm_phase<EpiOut>(lds, g, S, E);
    }
    SEAM(3);
    if (IN(4)) {
        pg8::Gemm g{XN, Wt_in_o, MTOK, 4096, DM}; pg8::StaticOrder S; S.init(MTOK, 4096, G, (int)blockIdx.x);
        EpiIn E{QKV, SSQ1, P.qkn_o, 1};
        pg8::gemm_phase<EpiIn>(lds, g, S, E);
    }
    SEAM(4);
    if (IN(5)) {
        if (wave == 0) { for (int it = blockIdx.x; it < 256; it += G) compress_unit(P, it, lane); }
        else { for (int it = blockIdx.x * (NWAVES - 1) + wave - 1; it < 1024; it += G * (NWAVES - 1)) kmean_unit(P, it, lane); }
    }
    SEAM(5);
    if (IN(6)) {
        for (;;) {
            const int u = next_unit(ctl + 128, lds);
            if (u >= 2048) break;
            if (u < 672) { if (EN_C) unit_C(P, (u & 31) >> 3, u & 7, 31 - (u >> 5), lds); }
            else if (u < 1696) { const int v = u - 672; if (EN_D) unit_D(P, (v & 7) >> 1, v & 1, 127 - (v >> 3), lds); }
            else { const int v = u - 1696; if (EN_C) unit_C(P, (v & 31) >> 3, v & 7, 10 - (v >> 5), lds); }
        }
    }
    SEAM(6);
    if (IN(7)) {
        pg8::Gemm g{MIXED, Wt_out_o, MTOK, DM, DM}; pg8::StaticOrder S; S.init(MTOK, DM, G, (int)blockIdx.x);
        EpiOut E{P.out, P.out, nullptr, nullptr};
        pg8::gemm_phase<EpiOut>(lds, g, S, E);
    }
#undef IN
#undef SEAM
}

extern "C" void kernel_launch(void* const* d_in, const int* in_sizes, int n_in, void* d_out, int out_size, void* d_ws, size_t ws_size, hipStream_t stream) {
    static int grid = 0;
    if (grid == 0) {
        if (n_in != 14 || in_sizes[0] != MTOK * DM || out_size != MTOK * DM || ws_size < WS_END) { fprintf(stderr, "kernel_launch: unexpected shapes (n_in %d, in0 %d, out %d, ws %zu)\n", n_in, n_in > 0 ? in_sizes[0] : -1, out_size, ws_size); grid = -1; return; }
        int dev = 0, cus = 0, per_cu = 0;
        hipGetDevice(&dev); hipDeviceGetAttribute(&cus, hipDeviceAttributeMultiprocessorCount, dev);
        if (hipFuncSetAttribute((const void*)mk_fwd, hipFuncAttributeMaxDynamicSharedMemorySize, LDS_BYTES) != hipSuccess) { fprintf(stderr, "kernel_launch: hipFuncSetAttribute failed\n"); grid = -1; return; }
        hipOccupancyMaxActiveBlocksPerMultiprocessor(&per_cu, (const void*)mk_fwd, NTHREADS, LDS_BYTES);
        (void)hipGetLastError();
        if (per_cu < 1) { fprintf(stderr, "kernel_launch: occupancy query says %d blocks per CU\n", per_cu); per_cu = 1; }
        grid = cus;
    }
    if (grid < 0) return;
    hipMemsetAsync((char*)d_ws + WS_CTL, 0, CTL_BYTES, stream);
    Params p{};
    p.x = (const float*)d_in[0]; p.ln_e = (const float*)d_in[1]; p.w_in_e = (const float*)d_in[2]; p.qkn_e = (const float*)d_in[3]; p.lam_e = (const float*)d_in[4];
    p.subln_e = (const float*)d_in[5]; p.w_out_e = (const float*)d_in[6]; p.ln_o = (const float*)d_in[7]; p.w_in_o = (const float*)d_in[8]; p.qkn_o = (const float*)d_in[9];
    p.phi_pe = (const float*)d_in[10]; p.phi_w1 = (const float*)d_in[11]; p.phi_w2 = (const float*)d_in[12]; p.w_out_o = (const float*)d_in[13];
    p.out = (float*)d_out; p.ws = (unsigned char*)d_ws;
#if MK_LAUNCHES == 1
    p.ph_lo = 0; p.ph_hi = 8;
    void* args[] = {&p};
    hipError_t e = hipLaunchCooperativeKernel((const void*)mk_fwd, dim3(grid), dim3(NTHREADS), args, LDS_BYTES, stream);
    if (e != hipSuccess) fprintf(stderr, "cooperative launch failed: %s (grid %d)\n", hipGetErrorString(e), grid);
#else
    for (int ph = 0; ph < 8; ++ph) { p.ph_lo = ph; p.ph_hi = ph + 1; hipLaunchKernelGGL(mk_fwd, dim3(grid), dim3(NTHREADS), LDS_BYTES, stream, p); }
#endif
}
```

```cpp
#include <hip/hip_runtime.h>
#include <hip/hip_cooperative_groups.h>
#include <cstdio>
#include <cstdint>
namespace cg = cooperative_groups;

#ifndef MK_LAUNCHES
#define MK_LAUNCHES 1
#endif

#ifndef EN_A
#define EN_A 1
#endif
#ifndef EN_B
#define EN_B 1
#endif
#ifndef EN_C
#define EN_C 1
#endif
#ifndef EN_D
#define EN_D 1
#endif
#ifndef REP_A
#define REP_A 1
#endif
#ifndef REP_B
#define REP_B 1
#endif
#ifndef REP_C
#define REP_C 1
#endif
#ifndef REP_D
#define REP_D 1
#endif
#ifndef REP_G1
#define REP_G1 1
#endif
#ifndef REP_G2
#define REP_G2 1
#endif
#ifndef REP_P0
#define REP_P0 1
#endif
#ifndef REP_P5
#define REP_P5 1
#endif
#define LAS __attribute__((address_space(3)))
typedef unsigned short bf16_t;
typedef short bf16x8 __attribute__((ext_vector_type(8)));
typedef short s16x4 __attribute__((ext_vector_type(4)));
typedef float f32x4 __attribute__((ext_vector_type(4)));
typedef float f32x16 __attribute__((ext_vector_type(16)));
typedef unsigned u32x4 __attribute__((ext_vector_type(4)));
typedef unsigned u32x2 __attribute__((ext_vector_type(2)));
typedef float f32x2_t __attribute__((ext_vector_type(2)));
typedef __bf16 bf16x2_t __attribute__((ext_vector_type(2)));

constexpr int BATCH = 4, SEQ = 8192, DM = 1024, MTOK = BATCH * SEQ, PQ = 4096;
constexpr int ODD_N = 3864;
constexpr float EPS = 1e-6f, LOG2E = 1.4426950408889634f, C2 = 0.125f * LOG2E;
constexpr float THR = 8.0f;
constexpr int NWAVES = 8, NTHREADS = 512;

constexpr size_t MiB = 1u << 20;
constexpr size_t WS_CTL = 0, CTL_BYTES = 32768;
constexpr size_t WS_WIN_E = 2 * MiB, WS_WOUT_E = 10 * MiB, WS_WIN_O = 12 * MiB, WS_WOUT_O = 20 * MiB;
constexpr size_t WS_W1T = 22 * MiB, WS_W2T = 23 * MiB, WS_BIAS1 = 23 * MiB + 65536, WS_KMEAN = 23 * MiB + 131072;
constexpr size_t WS_KCMP = 24 * MiB, WS_VCMP = 24 * MiB + 524288;
constexpr size_t WS_SSQ0 = 26 * MiB, WS_SSQ1 = 28 * MiB;
constexpr size_t WS_XN = 32 * MiB, WS_MIXED = 96 * MiB, WS_QKV = 160 * MiB, WS_END = 416 * MiB;

constexpr int RING_BYTES = 131072, LDSCTL_OFF = 143360, LDS_BYTES = 147456;

__device__ __forceinline__ unsigned f2bf(float f) { unsigned u = __builtin_bit_cast(unsigned, f); return (u + 0x7fffu + ((u >> 16) & 1u)) >> 16; }
__device__ __forceinline__ unsigned pk2(float lo, float hi) { return f2bf(lo) | (f2bf(hi) << 16); }
__device__ __forceinline__ float bf2f(unsigned b) { return __builtin_bit_cast(float, b << 16); }
__device__ __forceinline__ unsigned cvtpk(float lo, float hi) { f32x2_t v = {lo, hi}; bf16x2_t b = __builtin_convertvector(v, bf16x2_t); return __builtin_bit_cast(unsigned, b); }
__device__ __forceinline__ int crow(int r, int hi) { return (r & 3) + 8 * (r >> 2) + 4 * hi; }
__device__ __forceinline__ float wave_sum(float v) {
#pragma unroll
    for (int o = 1; o < 64; o <<= 1) v += __shfl_xor(v, o);
    return v;
}
__device__ __forceinline__ float swap_add(float v) { auto rr = __builtin_amdgcn_permlane32_swap(__float_as_uint(v), __float_as_uint(v), false, false); return __uint_as_float(rr[0]) + __uint_as_float(rr[1]); }
__device__ __forceinline__ float swap_max(float v) { auto rr = __builtin_amdgcn_permlane32_swap(__float_as_uint(v), __float_as_uint(v), false, false); return fmaxf(__uint_as_float(rr[0]), __uint_as_float(rr[1])); }
__device__ __forceinline__ void glds16(const void* g, LAS void* l) { __builtin_amdgcn_global_load_lds((const unsigned*)g, (LAS unsigned*)l, 16, 0, 0); }
#define LDS_WAIT() asm volatile("s_waitcnt lgkmcnt(0)" ::: "memory")
#define VM_WAIT() asm volatile("s_waitcnt vmcnt(0)" ::: "memory")

namespace pg8 {
constexpr int BM = 256, BK = 64, HALF = 128, HTB = HALF * BK * 2, NXCD = 8, WGM = 8;
__host__ __device__ __forceinline__ int lds_byte(int r, int c) { const int st = (r >> 4) * 2 + (c >> 5), rr = r & 15, cc = c & 31, ob = rr * 64 + cc * 2; return st * 1024 + (ob ^ (((ob >> 9) & 1) << 5)); }
__host__ __device__ __forceinline__ void stage_rc(int b, int& R, int& C) { const int st = b / 1024, sb = b % 1024, swz = sb ^ (((sb >> 9) & 1) << 5); R = (st >> 1) * 16 + swz / 64; C = (st & 1) * 32 + (swz % 64) / 2; }
__host__ __device__ __forceinline__ int perm32(int rho) { const int n = rho >> 4, i = rho & 15; return 8 * (i >> 2) + 4 * n + (i & 3); }
struct Unit { int pm, pn; };
struct Gemm { const bf16_t* A; const bf16_t* Bt; int M, N, K; };
struct StaticOrder {
    int nM, nN, nwg, G, c;
    __device__ void init(int M, int N, int G_, int c_) { nM = M / BM; nN = N / BM; nwg = nM * nN; G = G_; c = c_; }
    __device__ bool next(int i, Unit& u) const {
        const long L = (long)i * G + c; if (L >= nwg) return false;
        int wgid = (int)L; { const int q = nwg / NXCD, r = nwg % NXCD, xcd = wgid % NXCD, off = wgid / NXCD; wgid = (xcd < r ? xcd * (q + 1) : r * (q + 1) + (xcd - r) * q) + off; }
        const int nig = WGM * nN, gid = wgid / nig, fm = gid * WGM, gsz = (nM - fm) < WGM ? (nM - fm) : WGM;
        u.pm = fm + ((wgid % nig) % gsz); u.pn = (wgid % nig) / gsz; return true;
    }
};

template <class Epi>
__device__ __forceinline__ void gemm_phase(LAS unsigned char* lds, const Gemm g, const StaticOrder& S, const Epi& E) {
    const int tid = threadIdx.x, wid = __builtin_amdgcn_readfirstlane(tid >> 6), lane = tid & 63, wr = wid >> 2, wc = wid & 3, fr = lane & 15, fq = lane >> 4;
    const int K = g.K, nt = K / BK;
    unsigned voffA[2], voffB[2];
#pragma unroll
    for (int i = 0; i < 2; ++i) { int R, C; stage_rc(tid * 16 + i * 8192, R, C); const int Rb = Epi::PERM ? ((R & ~31) + perm32(R & 31)) : R;
        voffA[i] = (unsigned)(R * K + C) * 2u; voffB[i] = (unsigned)(Rb * K + C) * 2u; }
    const size_t kstep = (size_t)(BK * 2);
    const size_t hstep = (size_t)HALF * K * 2;
    const size_t tstep = 2 * hstep;
    const unsigned ldsw = (unsigned)wid * 1024u;
    const int aoff = lds_byte(wr * 64 + fr, fq * 8), boff = lds_byte(wc * 32 + fr, fq * 8);
#define PG8_SA(b, h) (((b) * 2 + (h)) * HTB)
#define PG8_SB(b, h) ((4 + (b) * 2 + (h)) * HTB)
#define PG8_STAGE(bufoff, gbase, voff) do { _Pragma("unroll") for (int _i = 0; _i < 2; ++_i) \
        __builtin_amdgcn_global_load_lds((const unsigned*)((const char*)(gbase) + (voff)[_i]), (LAS unsigned*)(lds + (bufoff) + ldsw + _i * 8192), 16, 0, 0); } while (0)
#define PG8_LDA(dst, b, h) do { _Pragma("unroll") for (int m = 0; m < 4; ++m) _Pragma("unroll") for (int k = 0; k < 2; ++k) dst[m][k] = *(const LAS bf16x8*)(lds + PG8_SA(b, h) + aoff + m * 2048 + k * 1024); } while (0)
#define PG8_LDB(dst, b, h) do { _Pragma("unroll") for (int n = 0; n < 2; ++n) _Pragma("unroll") for (int k = 0; k < 2; ++k) dst[n][k] = *(const LAS bf16x8*)(lds + PG8_SB(b, h) + boff + n * 2048 + k * 1024); } while (0)
#define PG8_MMA(ai, bj, At, Bt) do { __builtin_amdgcn_s_setprio(1); _Pragma("unroll") for (int m = 0; m < 4; ++m) _Pragma("unroll") for (int n = 0; n < 2; ++n) _Pragma("unroll") for (int k = 0; k < 2; ++k) \
        acc[ai][bj][m][n] = __builtin_amdgcn_mfma_f32_16x16x32_bf16(Bt[n][k], At[m][k], acc[ai][bj][m][n], 0, 0, 0); __builtin_amdgcn_s_setprio(0); } while (0)
#define PG8_WAIT_V(n) asm volatile("s_waitcnt vmcnt(" #n ")" ::: "memory")
#define PG8_WAIT_L(n) asm volatile("s_waitcnt lgkmcnt(" #n ")" ::: "memory")
#define PG8_BAR __builtin_amdgcn_s_barrier()
#define PG8_SCHED __builtin_amdgcn_sched_barrier(0)
    Unit cur, nxt; int ui = 0;
    if (!S.next(0, cur)) return;
    f32x4 acc[2][2][4][2];
#pragma unroll
    for (int a = 0; a < 2; ++a)
#pragma unroll
        for (int b = 0; b < 2; ++b)
#pragma unroll
            for (int m = 0; m < 4; ++m)
#pragma unroll
                for (int n = 0; n < 2; ++n) acc[a][b][m][n] = (f32x4){0.f, 0.f, 0.f, 0.f};
    bf16x8 At[4][2], B0[2][2], B1[2][2];
    const char* cA = (const char*)g.A + (size_t)cur.pm * tstep; const char* cB = (const char*)g.Bt + (size_t)cur.pn * tstep;
    PG8_STAGE(PG8_SB(0, 0), cB, voffB); PG8_STAGE(PG8_SB(0, 1), cB + hstep, voffB); PG8_STAGE(PG8_SA(0, 0), cA, voffA); PG8_STAGE(PG8_SA(0, 1), cA + hstep, voffA);
    if (wr == 1) PG8_BAR;
    PG8_WAIT_V(2); PG8_BAR;
    PG8_STAGE(PG8_SB(1, 0), cB + kstep, voffB); PG8_STAGE(PG8_SA(1, 0), cA + kstep, voffA); PG8_STAGE(PG8_SB(1, 1), cB + hstep + kstep, voffB);
    PG8_WAIT_V(6); PG8_BAR;
    for (;;) {
        const bool has_next = S.next(ui + 1, nxt);
        const char* nA = has_next ? (const char*)g.A + (size_t)nxt.pm * tstep : cA; const char* nB = has_next ? (const char*)g.Bt + (size_t)nxt.pn * tstep : cB;
        for (int t = 0; t < nt; t += 2) {
            const bool last = (t == nt - 2);
            const char* a1 = cA + (size_t)(t + 1) * kstep;
            const char* a2 = last ? nA : cA + (size_t)(t + 2) * kstep; const char* b2 = last ? nB : cB + (size_t)(t + 2) * kstep;
            const char* a3 = a2 + kstep; const char* b3 = b2 + kstep;
            PG8_LDB(B0, 0, 0); PG8_LDB(B1, 0, 1); PG8_SCHED; PG8_LDA(At, 0, 0); PG8_STAGE(PG8_SA(1, 1), a1 + hstep, voffA);
            PG8_WAIT_V(8); PG8_WAIT_L(0); PG8_BAR; PG8_MMA(0, 0, At, B0); PG8_MMA(0, 1, At, B1); PG8_BAR; PG8_SCHED;
            PG8_LDA(At, 0, 1); PG8_STAGE(PG8_SB(0, 0), b2, voffB); PG8_STAGE(PG8_SB(0, 1), b2 + hstep, voffB); PG8_STAGE(PG8_SA(0, 0), a2, voffA);
            PG8_WAIT_V(8); PG8_WAIT_L(0); PG8_BAR; PG8_MMA(1, 0, At, B0); PG8_MMA(1, 1, At, B1); PG8_BAR; PG8_SCHED;
            PG8_LDB(B0, 1, 0); PG8_LDB(B1, 1, 1); PG8_SCHED; PG8_LDA(At, 1, 0); PG8_STAGE(PG8_SA(0, 1), a2 + hstep, voffA);
            PG8_WAIT_V(8); PG8_WAIT_L(0); PG8_BAR; PG8_MMA(0, 0, At, B0); PG8_MMA(0, 1, At, B1); PG8_BAR; PG8_SCHED;
            PG8_LDA(At, 1, 1); PG8_STAGE(PG8_SB(1, 0), b3, voffB); PG8_STAGE(PG8_SB(1, 1), b3 + hstep, voffB); PG8_STAGE(PG8_SA(1, 0), a3, voffA);
            PG8_WAIT_V(8); PG8_WAIT_L(0); PG8_BAR; PG8_MMA(1, 0, At, B0); PG8_MMA(1, 1, At, B1); PG8_BAR; PG8_SCHED;
        }
        if (wr == 0) PG8_BAR;
        E(acc, cur, wr, wc, fr, fq);
        if (!has_next) break;
#pragma unroll
        for (int a = 0; a < 2; ++a)
#pragma unroll
            for (int b = 0; b < 2; ++b)
#pragma unroll
                for (int m = 0; m < 4; ++m)
#pragma unroll
                    for (int n = 0; n < 2; ++n) acc[a][b][m][n] = (f32x4){0.f, 0.f, 0.f, 0.f};
        cur = nxt; cA = nA; cB = nB; ++ui;
        if (wr == 1) PG8_BAR;
    }
    PG8_WAIT_V(0);
    PG8_BAR;
#undef PG8_SA
#undef PG8_SB
#undef PG8_STAGE
#undef PG8_LDA
#undef PG8_LDB
#undef PG8_MMA
#undef PG8_WAIT_V
#undef PG8_WAIT_L
#undef PG8_BAR
#undef PG8_SCHED
}
}


#define XB_TMO      128
#define XB_XCNT(j)  (256  + 64 * (j))
#define XB_XSUB(j)  (1280 + 64 * (j))
#define XB_XGEN(j)  (2304 + 64 * (j))
#define XB_TOP      3328
#define XB_TOPGEN   3392
#define XCD_BAR_WORDS 3456
#define XB_SPIN_CAP (1u << 18)
__device__ __forceinline__ unsigned xb_ld(unsigned* p)              { return __hip_atomic_load(p, __ATOMIC_RELAXED, __HIP_MEMORY_SCOPE_AGENT); }
__device__ __forceinline__ unsigned xb_add(unsigned* p, unsigned v) { return __hip_atomic_fetch_add(p, v, __ATOMIC_RELAXED, __HIP_MEMORY_SCOPE_AGENT); }
__device__ __forceinline__ unsigned xb_xcc_id() { return (unsigned)__builtin_amdgcn_s_getreg((3 << 11) | 20) & 0xFu; }
#define XB_SPIN(cond, bar) do { unsigned _sp = 0; while (cond) { __builtin_amdgcn_s_sleep(1); \
    if ((++_sp & 255u) == 0u) { if (xb_ld(&(bar)[XB_TMO])) break; if (_sp > XB_SPIN_CAP) { atomicAdd(&(bar)[XB_TMO], 1u); break; } } } } while (0)
struct XcdBarrier { unsigned* bar; unsigned x; volatile LAS unsigned* st; };
__device__ __forceinline__ XcdBarrier xcd_barrier_post(unsigned* bar, volatile LAS unsigned* st) {
    XcdBarrier b; b.bar = bar; b.x = xb_xcc_id(); b.st = st;
    if (threadIdx.x == 0) (void)xb_add(&bar[XB_XCNT(b.x)], 1u);
    return b;
}
__device__ __forceinline__ void xcd_barrier_complete(unsigned* bar, unsigned x, unsigned& nloc, unsigned& nx) {
    const unsigned G = gridDim.x * gridDim.y * gridDim.z;
    unsigned sum, cnt, mine, sp = 0u;
    for (;;) {
        sum = 0u; cnt = 0u; mine = 0u;
#pragma unroll
        for (unsigned j = 0; j < 16; ++j) { const unsigned c = xb_ld(&bar[XB_XCNT(j)]); sum += c; cnt += (c > 0u) ? 1u : 0u; mine = (j == x) ? c : mine; }
        if (sum == G) break;
        __builtin_amdgcn_s_sleep(1);
        if ((++sp & 255u) == 0u) { if (xb_ld(&bar[XB_TMO])) break; if (sp > XB_SPIN_CAP) { atomicAdd(&bar[XB_TMO], 1u); break; } }
    }
    nloc = mine > 0u ? mine : 1u; nx = cnt > 0u ? cnt : 1u;
}
__device__ __forceinline__ void xcd_barrier(const XcdBarrier& b) {
    asm volatile("s_waitcnt vmcnt(0)" ::: "memory");
    __syncthreads();
    if (threadIdx.x == 0) {
        unsigned* bar = b.bar;
        __builtin_amdgcn_s_waitcnt(0);
        unsigned nloc = b.st[0], nx = b.st[1];
        if (nloc == 0u) { xcd_barrier_complete(bar, b.x, nloc, nx); b.st[0] = nloc; b.st[1] = nx; }
        const unsigned old = xb_add(&bar[XB_XSUB(b.x)], 1u);
        const unsigned gen = old / nloc;
        if (old + 1u == (gen + 1u) * nloc) {
            __builtin_amdgcn_fence(__ATOMIC_RELEASE, "agent");
            asm volatile("s_waitcnt vmcnt(0)" ::: "memory");
            const unsigned og = xb_add(&bar[XB_TOP], 1u);
            const unsigned tg = og / nx;
            if (og + 1u == (tg + 1u) * nx) xb_add(&bar[XB_TOPGEN], 1u);
            else XB_SPIN(xb_ld(&bar[XB_TOPGEN]) == tg, bar);
            __builtin_amdgcn_fence(__ATOMIC_ACQUIRE, "agent");
            xb_add(&bar[XB_XGEN(b.x)], 1u);
            asm volatile("s_waitcnt vmcnt(0)" ::: "memory");
        } else {
            XB_SPIN(xb_ld(&bar[XB_XGEN(b.x)]) == gen, bar);
            __builtin_amdgcn_fence(__ATOMIC_ACQUIRE, "agent");
            asm volatile("s_waitcnt vmcnt(0)" ::: "memory");
        }
    }
    __syncthreads();
}

struct Params {
    const float* x; const float* ln_e; const float* w_in_e; const float* qkn_e; const float* lam_e; const float* subln_e; const float* w_out_e;
    const float* ln_o; const float* w_in_o; const float* qkn_o; const float* phi_pe; const float* phi_w1; const float* phi_w2; const float* w_out_o;
    float* out; unsigned char* ws;
    int ph_lo, ph_hi;
};

enum { OP_COPY = 0, OP_NORM = 1, OP_SILU = 2, OP_SIGM = 3 };
__device__ __forceinline__ void group_op(int layer, int G, const float* qkn, int& type, const float*& gain, float& scale) {
    type = OP_COPY; gain = qkn; scale = 1.f;
    if (layer == 0) {
        const int s = G >> 3;
        if (s == 0) { type = OP_NORM; gain = qkn; scale = C2; }
        else if (s == 1) { type = OP_NORM; gain = qkn + 64; }
        else if (s == 3 || s == 7) type = OP_SILU;
        else if (s == 4) { type = OP_NORM; gain = qkn + 128; scale = C2; }
        else if (s == 5) { type = OP_NORM; gain = qkn + 192; }
    } else {
        if (G < 8) { type = OP_NORM; gain = qkn; scale = C2; }
        else if (G < 16) { type = OP_NORM; gain = qkn + 64; }
        else if (G < 24) type = OP_COPY;
        else if (G < 32) type = OP_SILU;
        else if (G < 40) { type = OP_NORM; gain = qkn + 128; scale = C2; }
        else if (G < 44) type = OP_COPY;
        else if (G < 46) { type = OP_NORM; gain = qkn + 256; }
        else if (G < 48) type = OP_COPY;
        else if (G < 50) { type = OP_NORM; gain = qkn + 320; }
        else if (G < 52) type = OP_COPY;
        else if (G < 60) type = OP_SILU;
        else if (G == 60) type = OP_SIGM;
    }
}

struct EpiIn {
    static constexpr bool PERM = true;
    bf16_t* O; const float* ssq; const float* qkn; int layer;
    __device__ __forceinline__ void operator()(const f32x4 (&acc)[2][2][4][2], const pg8::Unit& u, int wr, int wc, int fr, int fq) const {
        int type; const float* gain; float scale; group_op(layer, u.pn * 4 + wc, qkn, type, gain, scale);
        f32x4 gv[2][2];
#pragma unroll
        for (int bj = 0; bj < 2; ++bj)
#pragma unroll
            for (int n = 0; n < 2; ++n) gv[bj][n] = (type == OP_NORM) ? *(const f32x4*)(gain + 32 * bj + 8 * fq + 4 * n) * scale : (f32x4){1.f, 1.f, 1.f, 1.f};
#pragma unroll
        for (int ai = 0; ai < 2; ++ai)
#pragma unroll
            for (int m = 0; m < 4; ++m) {
                const int row = u.pm * 256 + ai * 128 + wr * 64 + m * 16 + fr;
                const f32x4* sp = (const f32x4*)(ssq + (size_t)row * 16);
                const f32x4 s0 = sp[0], s1 = sp[1], s2 = sp[2], s3 = sp[3];
                const float tot = ((s0[0] + s0[1]) + (s0[2] + s0[3])) + ((s1[0] + s1[1]) + (s1[2] + s1[3])) + ((s2[0] + s2[1]) + (s2[2] + s2[3])) + ((s3[0] + s3[1]) + (s3[2] + s3[3]));
                const float rstd = __builtin_amdgcn_rsqf(tot * (1.0f / DM) + EPS);
                f32x4 v[2][2];
#pragma unroll
                for (int bj = 0; bj < 2; ++bj)
#pragma unroll
                    for (int n = 0; n < 2; ++n) v[bj][n] = acc[ai][bj][m][n] * rstd;
                if (type == OP_NORM) {
                    float ss = 0.f;
#pragma unroll
                    for (int bj = 0; bj < 2; ++bj)
#pragma unroll
                        for (int n = 0; n < 2; ++n) { const f32x4 t = v[bj][n]; ss += (t[0] * t[0] + t[1] * t[1]) + (t[2] * t[2] + t[3] * t[3]); }
                    ss += __shfl_xor(ss, 16); ss += __shfl_xor(ss, 32);
                    const float r = __builtin_amdgcn_rsqf(ss * (1.0f / 64.0f) + EPS);
#pragma unroll
                    for (int bj = 0; bj < 2; ++bj)
#pragma unroll
                        for (int n = 0; n < 2; ++n) v[bj][n] = v[bj][n] * r * gv[bj][n];
                } else if (type == OP_SILU || type == OP_SIGM) {
#pragma unroll
                    for (int bj = 0; bj < 2; ++bj)
#pragma unroll
                        for (int n = 0; n < 2; ++n)
#pragma unroll
                            for (int e = 0; e < 4; ++e) { const float t = v[bj][n][e]; const float sg = 1.0f / (1.0f + __builtin_amdgcn_exp2f(-t * LOG2E)); v[bj][n][e] = (type == OP_SILU) ? t * sg : sg; }
                }
                bf16_t* rowp = O + (size_t)row * PQ + u.pn * 256 + 64 * wc + 8 * fq;
#pragma unroll
                for (int bj = 0; bj < 2; ++bj) { u32x4 w; w.x = cvtpk(v[bj][0][0], v[bj][0][1]); w.y = cvtpk(v[bj][0][2], v[bj][0][3]); w.z = cvtpk(v[bj][1][0], v[bj][1][1]); w.w = cvtpk(v[bj][1][2], v[bj][1][3]);
                    *(u32x4*)(rowp + 32 * bj) = w; }
            }
    }
};

struct EpiOut {
    static constexpr bool PERM = false;
    const float* res; float* out; bf16_t* xn; float* ssq;
    __device__ __forceinline__ void operator()(const f32x4 (&acc)[2][2][4][2], const pg8::Unit& u, int wr, int wc, int fr, int fq) const {
#pragma unroll
        for (int ai = 0; ai < 2; ++ai)
#pragma unroll
            for (int m = 0; m < 4; ++m) {
                const int row = u.pm * 256 + ai * 128 + wr * 64 + m * 16 + fr; float ss = 0.f;
#pragma unroll
                for (int bj = 0; bj < 2; ++bj)
#pragma unroll
                    for (int n = 0; n < 2; ++n) {
                        const size_t off = (size_t)row * DM + u.pn * 256 + 128 * bj + 32 * wc + 16 * n + 4 * fq;
                        const f32x4 o = *(const f32x4*)(res + off) + acc[ai][bj][m][n];
                        *(f32x4*)(out + off) = o;
                        if (xn) { u32x2 w; w.x = cvtpk(o[0], o[1]); w.y = cvtpk(o[2], o[3]); *(u32x2*)(xn + off) = w; ss += (o[0] * o[0] + o[1] * o[1]) + (o[2] * o[2] + o[3] * o[3]); }
                    }
                if (xn) { ss += __shfl_xor(ss, 16); ss += __shfl_xor(ss, 32); if (fq == 0) ssq[(size_t)row * 16 + u.pn * 4 + wc] = ss; }
            }
    }
};

__device__ __forceinline__ int physrow(int L) { const int Lt = L & 255; return (L - Lt) + 128 * ((Lt >> 5) & 1) + 32 * (Lt >> 6) + (Lt & 31); }
__device__ __forceinline__ void transpose_item(const float* W, int K, int N, bf16_t* WT, bool permute, const float* g, LAS float* scr, int item, int lane, int nblk) {
    const int kb = item / nblk, nb = item % nblk, k0 = 64 * kb, n0 = 32 * nb;
    const int n = n0 + (lane & 31);
#pragma unroll 8
    for (int i = 0; i < 32; ++i) { const int kk = 2 * i + (lane >> 5); float v = (n < N) ? W[(size_t)(k0 + kk) * N + n] : 0.f; if (g) v *= g[k0 + kk]; scr[kk * 33 + (lane & 31)] = v; }
    LDS_WAIT();
    const int c = lane & 7; const int prow0 = permute ? physrow(n0) : n0;
#pragma unroll
    for (int j = 0; j < 4; ++j) { const int nn = (lane >> 3) + 8 * j; const LAS float* s = scr + (8 * c) * 33 + nn;
        u32x4 o; o.x = pk2(s[0 * 33], s[1 * 33]); o.y = pk2(s[2 * 33], s[3 * 33]); o.z = pk2(s[4 * 33], s[5 * 33]); o.w = pk2(s[6 * 33], s[7 * 33]);
        *(u32x4*)(WT + (size_t)(prow0 + nn) * K + k0 + 8 * c) = o; }
    LDS_WAIT();
}

__device__ __forceinline__ s16x4 vtr(const LAS char* p) { return __builtin_bit_cast(s16x4, __builtin_amdgcn_ds_read_tr16_b64_v4i16((LAS s16x4*)p)); }

__device__ __forceinline__ void qk_tile(f32x16& p0, f32x16& p1, const LAS char* Kt, const bf16x8 (&qr)[4], float cb, float stepk, int r32, int hi) {
    f32x16 c0, c1;
    const float cbh = cb + stepk * (float)(4 * hi), cbh1 = cbh + stepk * 32.f;
#pragma unroll
    for (int r = 0; r < 16; ++r) { c0[r] = __builtin_fmaf(stepk, (float)((r & 3) + 8 * (r >> 2)), cbh); c1[r] = __builtin_fmaf(stepk, (float)((r & 3) + 8 * (r >> 2)), cbh1); }
    const LAS char* kb = Kt + hi * 1024 + r32 * 16;
#pragma unroll
    for (int d0 = 0; d0 < 4; ++d0) {
        const bf16x8 b0 = *(const LAS bf16x8*)(kb + d0 * 2048);
        const bf16x8 b1 = *(const LAS bf16x8*)(kb + d0 * 2048 + 512);
        if (d0 == 0) { p0 = __builtin_amdgcn_mfma_f32_32x32x16_bf16(b0, qr[0], c0, 0, 0, 0); p1 = __builtin_amdgcn_mfma_f32_32x32x16_bf16(b1, qr[0], c1, 0, 0, 0); }
        else { p0 = __builtin_amdgcn_mfma_f32_32x32x16_bf16(b0, qr[d0], p0, 0, 0, 0); p1 = __builtin_amdgcn_mfma_f32_32x32x16_bf16(b1, qr[d0], p1, 0, 0, 0); }
    }
}
__device__ __forceinline__ void mask_tile(f32x16& p0, f32x16& p1, int dq0, int pstride, int dmin, int dmaxe, int hi) {
    const float NEG = -INFINITY;
#pragma unroll
    for (int r = 0; r < 16; ++r) {
        const int d = dq0 - pstride * crow(r, hi), d1 = d - 32 * pstride;
        if (d < dmin || d > dmaxe) p0[r] = NEG;
        if (d1 < dmin || d1 > dmaxe) p1[r] = NEG;
    }
}
__device__ __forceinline__ float rowmax32(const f32x16& p0, const f32x16& p1) {
    float a = fmaxf(p0[0], p1[0]);
#pragma unroll
    for (int r = 1; r < 16; ++r) a = fmaxf(fmaxf(a, p0[r]), p1[r]);
    return swap_max(a);
}
__device__ __forceinline__ void pack_p(bf16x8 (&pw)[4], const f32x16& p0, const f32x16& p1) {
    u32x4 a, b, c, d;
    a.x = cvtpk(p0[0], p0[1]); a.y = cvtpk(p0[2], p0[3]); a.z = cvtpk(p0[4], p0[5]); a.w = cvtpk(p0[6], p0[7]);
    b.x = cvtpk(p0[8], p0[9]); b.y = cvtpk(p0[10], p0[11]); b.z = cvtpk(p0[12], p0[13]); b.w = cvtpk(p0[14], p0[15]);
    c.x = cvtpk(p1[0], p1[1]); c.y = cvtpk(p1[2], p1[3]); c.z = cvtpk(p1[4], p1[5]); c.w = cvtpk(p1[6], p1[7]);
    d.x = cvtpk(p1[8], p1[9]); d.y = cvtpk(p1[10], p1[11]); d.z = cvtpk(p1[12], p1[13]); d.w = cvtpk(p1[14], p1[15]);
    pw[0] = __builtin_bit_cast(bf16x8, a); pw[1] = __builtin_bit_cast(bf16x8, b); pw[2] = __builtin_bit_cast(bf16x8, c); pw[3] = __builtin_bit_cast(bf16x8, d);
}
template <int NDB>
__device__ __forceinline__ void pv_tile(f32x16 (&oT)[NDB], const LAS char* Vt, const bf16x8 (&pw)[4], int lane) {
    const int hi = lane >> 5;
    const LAS char* vb = Vt + ((lane >> 4) & 1) * 32 + (lane & 3) * 8 + (4 * hi + ((lane & 15) >> 2)) * 64;
#pragma unroll
    for (int db = 0; db < NDB; ++db)
#pragma unroll
        for (int ks = 0; ks < 4; ++ks) {
            const s16x4 lo = vtr(vb + db * 4096 + ks * 1024), hh = vtr(vb + db * 4096 + ks * 1024 + 512);
            const bf16x8 vf = (bf16x8){lo[0], lo[1], lo[2], lo[3], hh[0], hh[1], hh[2], hh[3]};
            oT[db] = __builtin_amdgcn_mfma_f32_32x32x16_bf16(vf, pw[ks], oT[db], 0, 0, 0);
            if (ks == 1 || ks == 3) __builtin_amdgcn_sched_barrier(0);
        }
}
template <int NDB>
__device__ __forceinline__ void attn_tile(const LAS char* Kt, const LAS char* Vt, const bf16x8 (&qr)[4], f32x16 (&oT)[NDB], float& mref, float& lsum,
                                          float cbase, float stepk, bool emask, int dq0, int pstride, int dmin, int dmaxe, int lane) {
    const int r32 = lane & 31, hi = lane >> 5;
    f32x16 p0, p1;
    qk_tile(p0, p1, Kt, qr, cbase - mref, stepk, r32, hi);
    if (emask) mask_tile(p0, p1, dq0, pstride, dmin, dmaxe, hi);
    const float mx = rowmax32(p0, p1);
    if (__any(mx > THR)) {
        const float d = fmaxf(mx, 0.f); mref += d;
#pragma unroll
        for (int r = 0; r < 16; ++r) { p0[r] -= d; p1[r] -= d; }
        const float a = __builtin_amdgcn_exp2f(-d); lsum *= a;
#pragma unroll
        for (int db = 0; db < NDB; ++db)
#pragma unroll
            for (int r = 0; r < 16; ++r) oT[db][r] *= a;
    }
    float s = 0.f;
#pragma unroll
    for (int r = 0; r < 16; ++r) { p0[r] = __builtin_amdgcn_exp2f(p0[r]); p1[r] = __builtin_amdgcn_exp2f(p1[r]); s += p0[r] + p1[r]; }
    lsum += s;
    bf16x8 pw[4]; pack_p(pw, p0, p1);
    pv_tile<NDB>(oT, Vt, pw, lane);
}

__device__ __forceinline__ void issue_k_piece(const bf16_t* colbase, size_t pitch, int tok_lane, LAS char* Kbuf, int piece) {
    glds16(colbase + (size_t)tok_lane * pitch + piece * 8, Kbuf + piece * 1024);
}
__device__ __forceinline__ void issue_v_piece(const bf16_t* colbase, size_t pitch, int tok_row, LAS char* Vbuf, int piece, int lane) {
    glds16(colbase + (size_t)tok_row * pitch + (piece >> 2) * 32 + (lane & 3) * 8, Vbuf + piece * 1024);
}
__device__ __forceinline__ int clampi(int v, int lo, int hi) { return v < lo ? lo : (v > hi ? hi : v); }

template <int NDB>
__device__ __forceinline__ void store_rows(const f32x16 (&o)[NDB], const bf16_t* zrow, bf16_t* orow, int hi) {
#pragma unroll
    for (int db = 0; db < NDB; ++db)
#pragma unroll
        for (int q4 = 0; q4 < 4; ++q4) {
            const int d = 32 * db + 8 * q4 + 4 * hi;
            const u32x2 zz = *(const u32x2*)(zrow + d);
            u32x2 w;
            w.x = cvtpk(o[db][4 * q4 + 0] * bf2f(zz.x & 0xffffu), o[db][4 * q4 + 1] * bf2f(zz.x >> 16));
            w.y = cvtpk(o[db][4 * q4 + 2] * bf2f(zz.y & 0xffffu), o[db][4 * q4 + 3] * bf2f(zz.y >> 16));
            *(u32x2*)(orow + d) = w;
            if (q4 == 3) asm volatile("" ::: "memory");
        }
}

__device__ __forceinline__ float qk_bound(const float* gq, const float* gk, int lane) {
    float a = fabsf(gq[lane]), b = fabsf(gk[lane]);
#pragma unroll
    for (int o = 1; o < 64; o <<= 1) { a = fmaxf(a, __shfl_xor(a, o)); b = fmaxf(b, __shfl_xor(b, o)); }
    return 8.0f * a * b * LOG2E * 1.02f + 0.5f;
}
constexpr float ZCUT = 152.0f;
__device__ __forceinline__ int first_tile(int q0, float qkb, float sl2) {
    const float dc = (qkb + ZCUT) / sl2; const int dcut = dc > 1.0e9f ? (1 << 30) : (int)dc + 1;
    const int num = q0 - 63 - dcut; return num <= 0 ? 0 : (num + 63) / 64;
}

__device__ __forceinline__ int next_unit(unsigned* ctr, LAS unsigned char* lds) {
    volatile LAS int* slot = (volatile LAS int*)(lds + LDSCTL_OFF);
    __syncthreads();
    if (threadIdx.x == 0) *slot = (int)atomicAdd(ctr, 1u);
    __syncthreads();
    return *slot;
}

__device__ __forceinline__ void unit_A(const Params& P, int u, LAS unsigned char* lds) {
    int tid_ = threadIdx.x; asm volatile("" : "+v"(tid_));
    const int tid = tid_, lane = tid & 63, w = __builtin_amdgcn_readfirstlane(tid >> 6), r32 = lane & 31, hi = lane >> 5;
    const int half = u & 1, span = (u >> 1) & 15, h = (u >> 5) & 7, b = u >> 8;
    const int ph = 8 * half + w, t0 = 512 * span;
    const int tq = t0 + ph + 16 * r32;
    const bf16_t* Q = (const bf16_t*)(P.ws + WS_QKV) + (size_t)b * SEQ * PQ;
    const bf16_t* qrow = Q + (size_t)tq * PQ + h * 64;
    bf16x8 qr[4];
#pragma unroll
    for (int d0 = 0; d0 < 4; ++d0) qr[d0] = *(const bf16x8*)(qrow + d0 * 16 + hi * 8);
    const float sl2 = __builtin_amdgcn_exp2f(-(float)(h + 1)) * LOG2E;
    const float qkb = qk_bound(P.qkn_e, P.qkn_e + 64, lane);
    f32x16 oT[2]; oT[0] = f32x16{}; oT[1] = f32x16{};
    float mref = 0.f, lsum = 0.f;
    LAS char* Kb = (LAS char*)lds + w * 16384; LAS char* Vb = Kb + 8192;
    const bf16_t* Kcol = Q + 512 + h * 64; const bf16_t* Vcol = Q + 1024 + h * 64;
#pragma unroll 1
    for (int pat = 0; pat < 3; ++pat) {
        const int pst = pat == 0 ? 1 : (pat == 1 ? 4 : 16), win = pat == 0 ? 128 : (pat == 1 ? 512 : 2048), ntile = pat == 0 ? 10 : (pat == 1 ? 4 : 3);
        const int pbase = pat == 0 ? (t0 - 128) : (t0 + ph - win);
        const float stepk = sl2 * (float)pst;
        const int dmaxe = win < tq ? win : tq;
#pragma unroll 1
        for (int k = 0; k < ntile; ++k) {
            const int p0 = pbase + 64 * pst * k, dq0 = tq - p0;
            const int dlo = dq0 - 63 * pst;
            const bool any_valid = __any((dq0 >= 0) && (dlo <= dmaxe) && (qkb - sl2 * (float)(dlo > 0 ? dlo : 0) - mref > -ZCUT));
            if (!any_valid) continue;
            LDS_WAIT();
            const int tokK = clampi(p0 + pst * lane, 0, SEQ - 1);
#pragma unroll
            for (int c = 0; c < 8; ++c) issue_k_piece(Kcol, PQ, tokK, Kb, c);
#pragma unroll
            for (int i = 0; i < 8; ++i) { const int tokV = clampi(p0 + pst * (16 * (i & 3) + (lane >> 2)), 0, SEQ - 1); issue_v_piece(Vcol, PQ, tokV, Vb, i, lane); }
            VM_WAIT();
            attn_tile<2>(Kb, Vb, qr, oT, mref, lsum, -sl2 * (float)dq0, stepk, true, dq0, pst, 0, dmaxe, lane);
        }
    }
    const float inv = 1.0f / swap_add(lsum);
#pragma unroll
    for (int db = 0; db < 2; ++db)
#pragma unroll
        for (int r = 0; r < 16; ++r) oT[db][r] *= inv;
    bf16_t* mixed = (bf16_t*)(P.ws + WS_MIXED) + ((size_t)b * SEQ + tq) * DM + h * 64;
    store_rows<2>(oT, Q + (size_t)tq * PQ + 1536 + h * 64, mixed, hi);
}

__device__ __forceinline__ void unit_B(const Params& P, int b, int h, int qb, LAS unsigned char* lds) {
    int tid_ = threadIdx.x; asm volatile("" : "+v"(tid_));
    const int tid = tid_, lane = tid & 63, w = __builtin_amdgcn_readfirstlane(tid >> 6), r32 = lane & 31, hi = lane >> 5;
    const int comp = w >> 2, qs = w & 3;
    const int tq = 128 * qb + 32 * qs + r32;
    const bf16_t* Q = (const bf16_t*)(P.ws + WS_QKV) + (size_t)b * SEQ * PQ;
    const bf16_t* qrow = Q + (size_t)tq * PQ + 2048 + h * 128 + comp * 64;
    bf16x8 qr[4];
#pragma unroll
    for (int d0 = 0; d0 < 4; ++d0) qr[d0] = *(const bf16x8*)(qrow + d0 * 16 + hi * 8);
    const float sl2 = __builtin_amdgcn_exp2f(-2.0f * (float)(h + 1)) * LOG2E;
    float lamv;
    { const float* lm = P.lam_e; const float a = lm[lane] * lm[64 + lane], c = lm[128 + lane] * lm[192 + lane];
      lamv = __expf(wave_sum(a)) - __expf(wave_sum(c)) + 0.2f; }
    f32x16 oT[4]; oT[0] = f32x16{}; oT[1] = f32x16{}; oT[2] = f32x16{}; oT[3] = f32x16{};
    float mref = 0.f, lsum = 0.f;
    const bf16_t* Kcol = Q + 2560 + h * 128; const bf16_t* Vcol = Q + 3072 + h * 128;
    const int NTall = 2 * qb + 2;
    const int kt_min = first_tile(128 * qb, qk_bound(P.qkn_e + 128, P.qkn_e + 192, lane), sl2);
    const int NT = NTall - kt_min;
    auto issue = [&](int kt, int s) {
        LAS char* Kb = (LAS char*)lds + s * 32768; LAS char* Vb = Kb + 16384;
        const int tk = 64 * kt + lane;
#pragma unroll
        for (int j = 0; j < 2; ++j) { const int pc = w + 8 * j; glds16(Kcol + (size_t)tk * PQ + (pc >> 3) * 64 + (pc & 7) * 8, Kb + pc * 1024); }
#pragma unroll
        for (int j = 0; j < 2; ++j) { const int pi = w + 8 * j; const int tv = 64 * kt + 16 * (pi & 3) + (lane >> 2); glds16(Vcol + (size_t)tv * PQ + (pi >> 2) * 32 + (lane & 3) * 8, Vb + pi * 1024); }
    };
    issue(NTall - 1, 0);
#pragma unroll 1
    for (int it = 0; it < NT; ++it) {
        const int kt = NTall - 1 - it;
        VM_WAIT(); __syncthreads();
        if (it + 1 < NT) issue(kt - 1, (it + 1) & 1);
        const LAS char* Kb = (const LAS char*)lds + (it & 1) * 32768 + comp * 8192; const LAS char* Vb = (const LAS char*)lds + (it & 1) * 32768 + 16384;
        const int dq0 = tq - 64 * kt;
        attn_tile<4>(Kb, Vb, qr, oT, mref, lsum, -sl2 * (float)dq0, sl2, kt >= 2 * qb, dq0, 1, 0, 1 << 30, lane);
    }
    LDS_WAIT(); __syncthreads();
    const float inv = 1.0f / swap_add(lsum);
    LAS float* scr = (LAS float*)lds + qs * 4096;
    if (comp == 1) {
        const float f = inv * lamv;
#pragma unroll
        for (int db = 0; db < 4; ++db)
#pragma unroll
            for (int r = 0; r < 16; ++r) scr[(db * 16 + r) * 64 + lane] = oT[db][r] * f;
    }
    LDS_WAIT(); __syncthreads();
    if (comp == 0) {
        float ss = 0.f;
#pragma unroll
        for (int db = 0; db < 4; ++db) {
#pragma unroll
            for (int r = 0; r < 16; ++r) { const float v = oT[db][r] * inv - scr[(db * 16 + r) * 64 + lane]; oT[db][r] = v; ss += v * v; }
            asm volatile("" ::: "memory");
        }
        ss = swap_add(ss);
        const float rr = __builtin_amdgcn_rsqf(ss * (1.0f / 128.0f) + EPS) * 0.8f;
        const float* sg = P.subln_e;
#pragma unroll
        for (int db = 0; db < 4; ++db) {
#pragma unroll
            for (int q4 = 0; q4 < 4; ++q4) { const f32x4 gq = *(const f32x4*)(sg + 32 * db + 8 * q4 + 4 * hi);
#pragma unroll
                for (int e = 0; e < 4; ++e) oT[db][4 * q4 + e] *= rr * gq[e]; }
            asm volatile("" ::: "memory");
        }
        bf16_t* mixed = (bf16_t*)(P.ws + WS_MIXED) + ((size_t)b * SEQ + tq) * DM + 512 + h * 128;
        store_rows<4>(oT, Q + (size_t)tq * PQ + 3584 + h * 128, mixed, hi);
    }
    LDS_WAIT();
}

__device__ __forceinline__ bool better(float av, int an, float bv, int bn) { return av > bv || (av == bv && an < bn); }
__device__ __forceinline__ void unit_C(const Params& P, int b, int h, int i, LAS unsigned char* lds) {
    int tid_ = threadIdx.x; asm volatile("" : "+v"(tid_));
    const int tid = tid_, lane = tid & 63, w = __builtin_amdgcn_readfirstlane(tid >> 6), r32 = lane & 31, hi = lane >> 5;
    const int tq = 256 * i + 32 * w + r32;
    const bf16_t* Q = (const bf16_t*)(P.ws + WS_QKV) + (size_t)b * SEQ * PQ;
    const bf16_t* qrow = Q + (size_t)tq * PQ + h * 64;
    bf16x8 qr[4];
#pragma unroll
    for (int d0 = 0; d0 < 4; ++d0) qr[d0] = *(const bf16x8*)(qrow + d0 * 16 + hi * 8);
    unsigned sel = 0u;
    if (i > 0) {
        const float* km = (const float*)(P.ws + WS_KMEAN) + (size_t)(b * 8 + h) * 32 * 64;
        LAS char* Th = (LAS char*)lds + 65536; LAS char* Tl = Th + 8192;
#pragma unroll
        for (int j = 0; j < 4; ++j) { const int idx = tid * 4 + j, n = idx >> 6, d = idx & 63; const float v = km[idx];
            const unsigned hb = f2bf(v); const unsigned lb = f2bf(v - bf2f(hb)); const int off = (d >> 3) * 1024 + n * 16 + (d & 7) * 2;
            *(LAS bf16_t*)(Th + off) = (bf16_t)hb; *(LAS bf16_t*)(Tl + off) = (bf16_t)lb; }
        LDS_WAIT(); __syncthreads();
        f32x16 g = f32x16{};
        const LAS char* kh = Th + hi * 1024 + r32 * 16; const LAS char* kl = Tl + hi * 1024 + r32 * 16;
#pragma unroll
        for (int d0 = 0; d0 < 4; ++d0) { g = __builtin_amdgcn_mfma_f32_32x32x16_bf16(*(const LAS bf16x8*)(kh + d0 * 2048), qr[d0], g, 0, 0, 0);
                                         g = __builtin_amdgcn_mfma_f32_32x32x16_bf16(*(const LAS bf16x8*)(kl + d0 * 2048), qr[d0], g, 0, 0, 0); }
        float v1 = -INFINITY, v2 = -INFINITY, v3 = -INFINITY; int n1 = 99, n2 = 99, n3 = 99;
#pragma unroll
        for (int r = 0; r < 16; ++r) { const int n = crow(r, hi); const float v = (n < i) ? g[r] : -INFINITY;
            if (v > v1) { v3 = v2; n3 = n2; v2 = v1; n2 = n1; v1 = v; n1 = n; }
            else if (v > v2) { v3 = v2; n3 = n2; v2 = v; n2 = n; }
            else if (v > v3) { v3 = v; n3 = n; } }
        float pv[3] = {__shfl_xor(v1, 32), __shfl_xor(v2, 32), __shfl_xor(v3, 32)}; int pn[3] = {__shfl_xor(n1, 32), __shfl_xor(n2, 32), __shfl_xor(n3, 32)};
#pragma unroll
        for (int k = 0; k < 3; ++k) { const float v = pv[k]; const int n = pn[k];
            if (better(v, n, v1, n1)) { v3 = v2; n3 = n2; v2 = v1; n2 = n1; v1 = v; n1 = n; }
            else if (better(v, n, v2, n2)) { v3 = v2; n3 = n2; v2 = v; n2 = n; }
            else if (better(v, n, v3, n3)) { v3 = v; n3 = n; } }
        if (v1 > -INFINITY) sel |= 1u << n1; if (v2 > -INFINITY) sel |= 1u << n2; if (v3 > -INFINITY) sel |= 1u << n3;
    }
    const float sl2 = __builtin_amdgcn_exp2f(-(float)(h + 1)) * LOG2E;
    f32x16 oT[2]; oT[0] = f32x16{}; oT[1] = f32x16{};
    float mref = 0.f, lsum = 0.f;
    const bf16_t* Kcol = Q + 512 + h * 64; const bf16_t* Vcol = Q + 1024 + h * 64;
    const int NTall = 4 * i + 4;
    const int NT = NTall - first_tile(256 * i, qk_bound(P.qkn_o, P.qkn_o + 64, lane), sl2);
    auto issue = [&](int kt, int s) {
        LAS char* Kb = (LAS char*)lds + s * 16384; LAS char* Vb = Kb + 8192;
        issue_k_piece(Kcol, PQ, 64 * kt + lane, Kb, w);
        issue_v_piece(Vcol, PQ, 64 * kt + 16 * (w & 3) + (lane >> 2), Vb, w, lane);
    };
    issue(NTall - 1, 0);
#pragma unroll 1
    for (int it = 0; it < NT; ++it) {
        const int kt = NTall - 1 - it;
        VM_WAIT(); __syncthreads();
        if (it + 1 < NT) issue(kt - 1, (it + 1) & 1);
        const LAS char* Kb = (const LAS char*)lds + (it & 1) * 16384; const LAS char* Vb = Kb + 8192;
        const int dq0 = tq - 64 * kt; const bool own = kt >= 4 * i;
        const bool on = own || ((sel >> (kt >> 2)) & 1u);
        if (!__any(on)) continue;
        attn_tile<2>(Kb, Vb, qr, oT, mref, lsum, on ? -sl2 * (float)dq0 : -INFINITY, sl2, own, dq0, 1, 0, 1 << 30, lane);
    }
    const float inv = 1.0f / swap_add(lsum);
#pragma unroll
    for (int db = 0; db < 2; ++db)
#pragma unroll
        for (int r = 0; r < 16; ++r) oT[db][r] *= inv;
    bf16_t* mixed = (bf16_t*)(P.ws + WS_MIXED) + ((size_t)b * SEQ + tq) * DM + h * 64;
    store_rows<2>(oT, Q + (size_t)tq * PQ + 1536 + h * 64, mixed, hi);
    LDS_WAIT();
}

constexpr int IMP_PITCH = 132;
__device__ __forceinline__ unsigned dpp_max_u32_8(unsigned v) {
    unsigned t;
    t = (unsigned)__builtin_amdgcn_update_dpp(0, (int)v, 0xB1, 0xF, 0xF, true); v = v > t ? v : t;
    t = (unsigned)__builtin_amdgcn_update_dpp(0, (int)v, 0x4E, 0xF, 0xF, true); v = v > t ? v : t;
    t = (unsigned)__builtin_amdgcn_update_dpp(0, (int)v, 0x141, 0xF, 0xF, true); v = v > t ? v : t;
    return v;
}
__device__ __forceinline__ void unit_D(const Params& P, int b, int hkv, int qt, LAS unsigned char* lds) {
    int tid_ = threadIdx.x; asm volatile("" : "+v"(tid_));
    const int tid = tid_, lane = tid & 63, w = __builtin_amdgcn_readfirstlane(tid >> 6), r32 = lane & 31, hi = lane >> 5;
    const int qi = r32 & 7, g = r32 >> 3, hq = 4 * hkv + g;
    const int ql = 8 * w + qi, tq = 64 * qt + ql;
    const bf16_t* Q = (const bf16_t*)(P.ws + WS_QKV) + (size_t)b * SEQ * PQ;
    const bf16_t* qrow = Q + (size_t)tq * PQ + 2048 + hq * 64;
    bf16x8 qr[4];
#pragma unroll
    for (int d0 = 0; d0 < 4; ++d0) qr[d0] = *(const bf16x8*)(qrow + d0 * 16 + hi * 8);
    const float sl2 = __builtin_amdgcn_exp2f(-(float)(hq + 1)) * LOG2E;
    LAS float* imp = (LAS float*)(lds + 32768);
    LAS unsigned short* selm = (LAS unsigned short*)(lds + 67584);
    LAS unsigned* uni = (LAS unsigned*)(lds + 68608);
    for (int k = tid; k < 64 * IMP_PITCH; k += NTHREADS) imp[k] = 0.f;
    if (tid < 4) uni[tid] = 0u;
    LAS float* stash = (LAS float*)(lds + 69632) + w * 2048 + lane;
    const bf16_t* gp = Q + (size_t)tq * PQ + 3840 + 3 * hq;

#ifndef D_NOCMP
    {
        const bf16_t* Kc = (const bf16_t*)(P.ws + WS_KCMP) + (size_t)(b * 2 + hkv) * 512 * 64;
        const bf16_t* Vc = (const bf16_t*)(P.ws + WS_VCMP) + (size_t)(b * 2 + hkv) * 512 * 64;
        const int NTc = (4 * qt + 2) / 64 + 1;
        const float stepk = sl2 * 16.f;
        auto issue = [&](int ti, int s, bool withv) {
            LAS char* Kb = (LAS char*)lds + s * 16384; LAS char* Vb = Kb + 8192;
            issue_k_piece(Kc, 64, 64 * ti + lane, Kb, w);
            if (withv) issue_v_piece(Vc, 64, 64 * ti + 16 * (w & 3) + (lane >> 2), Vb, w, lane);
        };
        float mref = 0.f, lsum = 0.f;
        issue(0, 0, false);
#pragma unroll 1
        for (int ti = 0; ti < NTc; ++ti) {
            VM_WAIT(); __syncthreads();
            if (ti + 1 < NTc) issue(ti + 1, (ti + 1) & 1, false);
            const LAS char* Kb = (const LAS char*)lds + (ti & 1) * 16384;
            const int dq0 = tq - (1024 * ti + 31);
            f32x16 p0, p1;
            qk_tile(p0, p1, Kb, qr, -sl2 * (float)dq0 - mref, stepk, r32, hi);
            mask_tile(p0, p1, dq0, 16, 0, 1 << 30, hi);
            const float mx = rowmax32(p0, p1);
            if (__any(mx > THR)) { const float d = fmaxf(mx, 0.f); mref += d;
#pragma unroll
                for (int r = 0; r < 16; ++r) { p0[r] -= d; p1[r] -= d; }
                lsum *= __builtin_amdgcn_exp2f(-d); }
            float s = 0.f;
#pragma unroll
            for (int r = 0; r < 16; ++r) s += __builtin_amdgcn_exp2f(p0[r]) + __builtin_amdgcn_exp2f(p1[r]);
            lsum += s;
        }
        const float ltot = swap_add(lsum);
        const float linv = ltot > 0.f ? 1.0f / ltot : 0.f;
        __syncthreads();
        f32x16 oT[2]; oT[0] = f32x16{}; oT[1] = f32x16{};
        issue(0, 0, true);
#pragma unroll 1
        for (int ti = 0; ti < NTc; ++ti) {
            VM_WAIT(); __syncthreads();
            if (ti + 1 < NTc) issue(ti + 1, (ti + 1) & 1, true);
            const LAS char* Kb = (const LAS char*)lds + (ti & 1) * 16384; const LAS char* Vb = Kb + 8192;
            const int dq0 = tq - (1024 * ti + 31);
            f32x16 p0, p1;
            qk_tile(p0, p1, Kb, qr, -sl2 * (float)dq0 - mref, stepk, r32, hi);
            mask_tile(p0, p1, dq0, 16, 0, 1 << 30, hi);
#pragma unroll
            for (int r = 0; r < 16; ++r) { p0[r] = __builtin_amdgcn_exp2f(p0[r]) * linv; p1[r] = __builtin_amdgcn_exp2f(p1[r]) * linv; }
#pragma unroll
            for (int hf = 0; hf < 2; ++hf)
#pragma unroll
                for (int c = 0; c < 4; ++c) {
                    const f32x16& pp = hf ? p1 : p0;
                    float G = (pp[4 * c] + pp[4 * c + 1]) + (pp[4 * c + 2] + pp[4 * c + 3]); float L = pp[4 * c + 3];
                    G += __shfl_xor(G, 8); G += __shfl_xor(G, 16); L += __shfl_xor(L, 8); L += __shfl_xor(L, 16);
                    const int j = 16 * ti + 8 * hf + 2 * c + hi;
                    if (g == 0) { LAS float* ip = imp + ql * IMP_PITCH + j; ip[0] += G; }
                    LDS_WAIT();
                    if (g == 0) { LAS float* ip = imp + ql * IMP_PITCH + j + 1; ip[0] += L; }
                    LDS_WAIT();
                }
            bf16x8 pw[4]; pack_p(pw, p0, p1);
            pv_tile<2>(oT, Vb, pw, lane);
        }
        const float g0 = bf2f(gp[0]);
#pragma unroll
        for (int db = 0; db < 2; ++db)
#pragma unroll
            for (int r = 0; r < 16; ++r) stash[(db * 16 + r) * 64] = g0 * oT[db][r];
    }
#endif
    LDS_WAIT(); __syncthreads();
#ifndef D_NOTOPK
    {
        const int qq = 8 * w + (lane >> 3), sub = lane & 7;
        unsigned key[16];
#pragma unroll
        for (int k = 0; k < 16; ++k) { const int j = 16 * sub + k; const float v = imp[qq * IMP_PITCH + j];
            unsigned kk = ((__float_as_uint(v) >> 7) << 7) + (unsigned)(128 - j);
            if (j == 0 || j == qt || j == qt - 1) kk = 0xFFFFFF00u | (unsigned)(128 - j);
            if (j > qt) kk = 0u;
            key[k] = kk; }
        unsigned selb = 0u;
#pragma unroll 1
        for (int round = 0; round < 16; ++round) {
            unsigned lm = key[0];
#pragma unroll
            for (int k = 1; k < 16; ++k) lm = key[k] > lm ? key[k] : lm;
            const unsigned gm = dpp_max_u32_8(lm);
            if (gm != 0u) {
#pragma unroll
                for (int k = 0; k < 16; ++k) { const bool hit = key[k] == gm; selb |= hit ? (1u << k) : 0u; key[k] = hit ? 0u : key[k]; }
            }
        }
        selm[qq * 8 + sub] = (unsigned short)selb;
    }
#endif
    LDS_WAIT(); __syncthreads();
    unsigned msk[4];
    { const LAS unsigned* mp = (const LAS unsigned*)(selm + ql * 8); msk[0] = mp[0]; msk[1] = mp[1]; msk[2] = mp[2]; msk[3] = mp[3]; }
    {
        unsigned o0 = msk[0], o1 = msk[1], o2 = msk[2], o3 = msk[3];
#pragma unroll
        for (int s = 1; s < 8; s <<= 1) { o0 |= __shfl_xor(o0, s); o1 |= __shfl_xor(o1, s); o2 |= __shfl_xor(o2, s); o3 |= __shfl_xor(o3, s); }
        if (lane == 0) { atomicOr((unsigned*)&uni[0], o0); atomicOr((unsigned*)&uni[1], o1); atomicOr((unsigned*)&uni[2], o2); atomicOr((unsigned*)&uni[3], o3); }
    }
    LDS_WAIT(); __syncthreads();
    unsigned um[4] = {uni[0], uni[1], uni[2], uni[3]};
    um[0] = __builtin_amdgcn_readfirstlane(um[0]); um[1] = __builtin_amdgcn_readfirstlane(um[1]); um[2] = __builtin_amdgcn_readfirstlane(um[2]); um[3] = __builtin_amdgcn_readfirstlane(um[3]);
#ifndef D_NOSLC
    {
        const bf16_t* Kcol = Q + 2816 + hkv * 64; const bf16_t* Vcol = Q + 2944 + hkv * 64;
        auto nextblk = [&](int below) -> int {
            for (int wd = 3; wd >= 0; --wd) { unsigned m = um[wd]; const int lim = below - 32 * wd; if (lim <= 0) continue; if (lim < 32) m &= (1u << lim) - 1u; if (m) return 32 * wd + 31 - __builtin_clz(m); }
            return -1;
        };
        auto issue = [&](int j, int s) {
            LAS char* Kb = (LAS char*)lds + s * 16384; LAS char* Vb = Kb + 8192;
            issue_k_piece(Kcol, PQ, 64 * j + lane, Kb, w);
            issue_v_piece(Vcol, PQ, 64 * j + 16 * (w & 3) + (lane >> 2), Vb, w, lane);
        };
        f32x16 oT[2]; oT[0] = f32x16{}; oT[1] = f32x16{};
        float mref = 0.f, lsum = 0.f;
        const int jmin = first_tile(64 * qt, qk_bound(P.qkn_o + 128, P.qkn_o + 256, lane), __builtin_amdgcn_exp2f(-(float)(4 * hkv + 4)) * LOG2E);
        int j = nextblk(128), it = 0;
        if (j < jmin) j = -1;
        if (j >= 0) issue(j, 0);
#pragma unroll 1
        while (j >= 0) {
            int jn = nextblk(j); if (jn < jmin) jn = -1;
            VM_WAIT(); __syncthreads();
            if (jn >= 0) issue(jn, (it + 1) & 1);
            const LAS char* Kb = (const LAS char*)lds + (it & 1) * 16384; const LAS char* Vb = Kb + 8192;
            const int dq0 = tq - 64 * j;
            const unsigned mw = j < 32 ? msk[0] : (j < 64 ? msk[1] : (j < 96 ? msk[2] : msk[3]));
            const bool on = (mw >> (j & 31)) & 1u;
            if (__any(on))
                attn_tile<2>(Kb, Vb, qr, oT, mref, lsum, on ? -sl2 * (float)dq0 : -INFINITY, sl2, j == qt, dq0, 1, 0, 1 << 30, lane);
            j = jn; ++it;
        }
        const float f = bf2f(gp[1]) / swap_add(lsum);
#pragma unroll
        for (int db = 0; db < 2; ++db)
#pragma unroll
            for (int r = 0; r < 16; ++r) stash[(db * 16 + r) * 64] += f * oT[db][r];
    }
#endif
    __syncthreads();
#ifndef D_NOWIN
    {
        const bf16_t* Kcol = Q + 3072 + hkv * 64; const bf16_t* Vcol = Q + 3200 + hkv * 64;
        auto issue = [&](int kt, int s) {
            LAS char* Kb = (LAS char*)lds + s * 16384; LAS char* Vb = Kb + 8192;
            issue_k_piece(Kcol, PQ, 64 * kt + lane, Kb, w);
            issue_v_piece(Vcol, PQ, 64 * kt + 16 * (w & 3) + (lane >> 2), Vb, w, lane);
        };
        f32x16 oT[2]; oT[0] = f32x16{}; oT[1] = f32x16{};
        float mref = 0.f, lsum = 0.f;
        const int klo = qt - 8 > 0 ? qt - 8 : 0, NT = qt - klo + 1;
        issue(qt, 0);
#pragma unroll 1
        for (int it = 0; it < NT; ++it) {
            const int kt = qt - it;
            VM_WAIT(); __syncthreads();
            if (it + 1 < NT) issue(kt - 1, (it + 1) & 1);
            const LAS char* Kb = (const LAS char*)lds + (it & 1) * 16384; const LAS char* Vb = Kb + 8192;
            const int dq0 = tq - 64 * kt;
            attn_tile<2>(Kb, Vb, qr, oT, mref, lsum, -sl2 * (float)dq0, sl2, (kt == qt) || (kt == qt - 8), dq0, 1, 0, 511, lane);
        }
        const float f = bf2f(gp[2]) / swap_add(lsum);
#pragma unroll
        for (int db = 0; db < 2; ++db)
#pragma unroll
            for (int r = 0; r < 16; ++r) oT[db][r] = stash[(db * 16 + r) * 64] + f * oT[db][r];
        bf16_t* mixed = (bf16_t*)(P.ws + WS_MIXED) + ((size_t)b * SEQ + tq) * DM + 512 + hq * 64;
        store_rows<2>(oT, Q + (size_t)tq * PQ + 3328 + hq * 64, mixed, hi);
    }
#endif
    LDS_WAIT();
}

__device__ __forceinline__ void kmean_unit(const Params& P, int u, int lane) {
    const int blk = u & 31, h = (u >> 5) & 7, b = u >> 8;
    const bf16_t* K = (const bf16_t*)(P.ws + WS_QKV) + ((size_t)b * SEQ + 256 * blk) * PQ + 512 + h * 64;
    float a[8] = {0.f, 0.f, 0.f, 0.f, 0.f, 0.f, 0.f, 0.f};
    const int c = lane & 7, rs = lane >> 3;
#pragma unroll 4
    for (int it = 0; it < 32; ++it) { const u32x4 v = *(const u32x4*)(K + (size_t)(8 * it + rs) * PQ + 8 * c);
        a[0] += bf2f(v.x & 0xffffu); a[1] += bf2f(v.x >> 16); a[2] += bf2f(v.y & 0xffffu); a[3] += bf2f(v.y >> 16);
        a[4] += bf2f(v.z & 0xffffu); a[5] += bf2f(v.z >> 16); a[6] += bf2f(v.w & 0xffffu); a[7] += bf2f(v.w >> 16); }
#pragma unroll
    for (int k = 0; k < 8; ++k) { float s = a[k]; s += __shfl_xor(s, 8); s += __shfl_xor(s, 16); s += __shfl_xor(s, 32); a[k] = s * (1.0f / 256.0f); }
    if (rs == 0) { float* o = (float*)(P.ws + WS_KMEAN) + (size_t)u * 64 + 8 * c;
        *(f32x4*)o = (f32x4){a[0], a[1], a[2], a[3]}; *(f32x4*)(o + 4) = (f32x4){a[4], a[5], a[6], a[7]}; }
}
__device__ __forceinline__ void compress_unit(const Params& P, int u, int lane) {
    const int chunk = u & 15, hkv = (u >> 4) & 1, b = (u >> 5) & 3, which = u >> 7;
    const int r32 = lane & 31, hi = lane >> 5;
    const int n = 32 * chunk + r32, nc = n > 510 ? 510 : n;
    const bf16_t* X = (const bf16_t*)(P.ws + WS_QKV) + ((size_t)b * SEQ + 16 * nc) * PQ + (which ? 2688 : 2560) + hkv * 64 + 8 * hi;
    const bf16_t* W1 = (const bf16_t*)(P.ws + WS_W1T) + (size_t)which * 128 * 2048 + (size_t)r32 * 2048 + 8 * hi;
    f32x16 hT[4]; hT[0] = f32x16{}; hT[1] = f32x16{}; hT[2] = f32x16{}; hT[3] = f32x16{};
#pragma unroll 4
    for (int ks = 0; ks < 128; ++ks) {
        const bf16x8 xb = *(const bf16x8*)(X + (size_t)(ks >> 2) * PQ + (ks & 3) * 16);
#pragma unroll
        for (int cb = 0; cb < 4; ++cb) { const bf16x8 wa = *(const bf16x8*)(W1 + (size_t)cb * 32 * 2048 + ks * 16);
            hT[cb] = __builtin_amdgcn_mfma_f32_32x32x16_bf16(wa, xb, hT[cb], 0, 0, 0); }
    }
    const float* b1 = (const float*)(P.ws + WS_BIAS1) + which * 128;
    const bf16_t* W2 = (const bf16_t*)(P.ws + WS_W2T) + (size_t)which * 64 * 128;
    f32x16 oT[2]; oT[0] = f32x16{}; oT[1] = f32x16{};
#pragma unroll
    for (int cb = 0; cb < 4; ++cb) {
#pragma unroll
        for (int r = 0; r < 16; ++r) { const float t = hT[cb][r] + b1[32 * cb + crow(r, hi)]; hT[cb][r] = t / (1.0f + __builtin_amdgcn_exp2f(-t * LOG2E)); }
#pragma unroll
        for (int s = 0; s < 2; ++s) {
            u32x4 pb; pb.x = cvtpk(hT[cb][8 * s + 0], hT[cb][8 * s + 1]); pb.y = cvtpk(hT[cb][8 * s + 2], hT[cb][8 * s + 3]); pb.z = cvtpk(hT[cb][8 * s + 4], hT[cb][8 * s + 5]); pb.w = cvtpk(hT[cb][8 * s + 6], hT[cb][8 * s + 7]);
            const bf16x8 bfrag = __builtin_bit_cast(bf16x8, pb);
#pragma unroll
            for (int ob = 0; ob < 2; ++ob) { const bf16_t* wp = W2 + (size_t)(32 * ob + r32) * 128 + 32 * cb + 16 * s + 4 * hi;
                const u32x2 a0 = *(const u32x2*)wp, a1 = *(const u32x2*)(wp + 8);
                const bf16x8 afrag = __builtin_bit_cast(bf16x8, (u32x4){a0.x, a0.y, a1.x, a1.y});
                oT[ob] = __builtin_amdgcn_mfma_f32_32x32x16_bf16(afrag, bfrag, oT[ob], 0, 0, 0); }
        }
    }
    if (which == 0) {
        float ss = 0.f;
#pragma unroll
        for (int ob = 0; ob < 2; ++ob)
#pragma unroll
            for (int r = 0; r < 16; ++r) ss += oT[ob][r] * oT[ob][r];
        ss = swap_add(ss);
        const float rr = __builtin_amdgcn_rsqf(ss * (1.0f / 64.0f) + EPS); const float* gn = P.qkn_o + 192;
#pragma unroll
        for (int ob = 0; ob < 2; ++ob)
#pragma unroll
            for (int r = 0; r < 16; ++r) oT[ob][r] *= rr * gn[32 * ob + crow(r, hi)];
    }
    bf16_t* orow = (bf16_t*)(P.ws + (which ? WS_VCMP : WS_KCMP)) + ((size_t)(b * 2 + hkv) * 512 + n) * 64;
#pragma unroll
    for (int ob = 0; ob < 2; ++ob)
#pragma unroll
        for (int q4 = 0; q4 < 4; ++q4) { u32x2 wv; wv.x = cvtpk(oT[ob][4 * q4], oT[ob][4 * q4 + 1]); wv.y = cvtpk(oT[ob][4 * q4 + 2], oT[ob][4 * q4 + 3]);
            *(u32x2*)(orow + 32 * ob + 8 * q4 + 4 * hi) = wv; }
}

__global__ void __launch_bounds__(NTHREADS, 2) mk_fwd(Params P) {
    extern __shared__ __attribute__((aligned(16))) unsigned char lds_raw[];
    LAS unsigned char* lds = (LAS unsigned char*)lds_raw;
    const int tid = threadIdx.x, lane = tid & 63, wave = __builtin_amdgcn_readfirstlane(tid >> 6);
    const int G = gridDim.x;
    const int gw = blockIdx.x * NWAVES + wave, NGW = G * NWAVES;
    unsigned* ctl = (unsigned*)(P.ws + WS_CTL);
    bf16_t* Wt_in_e = (bf16_t*)(P.ws + WS_WIN_E); bf16_t* Wt_out_e = (bf16_t*)(P.ws + WS_WOUT_E);
    bf16_t* Wt_in_o = (bf16_t*)(P.ws + WS_WIN_O); bf16_t* Wt_out_o = (bf16_t*)(P.ws + WS_WOUT_O);
    bf16_t* XN = (bf16_t*)(P.ws + WS_XN); bf16_t* MIXED = (bf16_t*)(P.ws + WS_MIXED); bf16_t* QKV = (bf16_t*)(P.ws + WS_QKV);
    float* SSQ0 = (float*)(P.ws + WS_SSQ0); float* SSQ1 = (float*)(P.ws + WS_SSQ1);
#if MK_LAUNCHES == 1
    cg::grid_group grid = cg::this_grid();
    volatile LAS unsigned* bst = (volatile LAS unsigned*)(lds + LDSCTL_OFF + 16);
    if (tid < 2) bst[tid] = 0u;
    __syncthreads();
    XcdBarrier xbar = xcd_barrier_post(ctl + 1024, bst);
#define SEAM(k) do { if (P.ph_lo <= (k) && (k) + 1 < P.ph_hi) { if ((k) == 0) grid.sync(); else xcd_barrier(xbar); } } while (0)
#else
#define SEAM(k) do { } while (0)
#endif
#define IN(k) (P.ph_lo <= (k) && (k) < P.ph_hi)

    if (IN(0)) {
        LAS float* scr = (LAS float*)(lds + wave * 16384);
        constexpr int I_IN = 16 * 128, I_OUT = 16 * 32, I_W1 = 32 * 4, I_W2 = 2 * 2;
        constexpr int NIT = 2 * I_IN + 2 * I_OUT + 2 * I_W1 + 2 * I_W2;
        for (int it = gw; it < NIT; it += NGW) {
            int r = it;
            if (r < I_IN) { transpose_item(P.w_in_e, DM, 4096, Wt_in_e, true, P.ln_e, scr, r, lane, 128); continue; } r -= I_IN;
            if (r < I_IN) { transpose_item(P.w_in_o, DM, ODD_N, Wt_in_o, true, P.ln_o, scr, r, lane, 128); continue; } r -= I_IN;
            if (r < I_OUT) { transpose_item(P.w_out_e, DM, DM, Wt_out_e, false, nullptr, scr, r, lane, 32); continue; } r -= I_OUT;
            if (r < I_OUT) { transpose_item(P.w_out_o, DM, DM, Wt_out_o, false, nullptr, scr, r, lane, 32); continue; } r -= I_OUT;
            if (r < 2 * I_W1) { const int wh = r / I_W1; transpose_item(P.phi_w1 + (size_t)wh * 2048 * 128, 2048, 128, (bf16_t*)(P.ws + WS_W1T) + (size_t)wh * 128 * 2048, false, nullptr, scr, r % I_W1, lane, 4); continue; } r -= 2 * I_W1;
            { const int wh = r / I_W2; transpose_item(P.phi_w2 + (size_t)wh * 128 * 64, 128, 64, (bf16_t*)(P.ws + WS_W2T) + (size_t)wh * 64 * 128, false, nullptr, scr, r % I_W2, lane, 2); }
        }
        for (int it = gw; it < 256; it += NGW) { const int wh = it >> 7, c = it & 127; const float* pe = P.phi_pe + (size_t)wh * 2048; const float* w1 = P.phi_w1 + (size_t)wh * 2048 * 128;
            float s = 0.f; for (int k = lane; k < 2048; k += 64) s += pe[k] * w1[(size_t)k * 128 + c]; s = wave_sum(s);
            if (lane == 0) ((float*)(P.ws + WS_BIAS1))[it] = s; }
        for (int m = gw; m < MTOK; m += NGW) {
            const f32x4* xr = (const f32x4*)(P.x + (size_t)m * DM) + lane; f32x4 v[4]; float s = 0.f;
#pragma unroll
            for (int j = 0; j < 4; ++j) { v[j] = xr[64 * j]; s += (v[j][0] * v[j][0] + v[j][1] * v[j][1]) + (v[j][2] * v[j][2] + v[j][3] * v[j][3]); }
            s = wave_sum(s);
            u32x2* o8 = (u32x2*)(XN + (size_t)m * DM) + lane;
#pragma unroll
            for (int j = 0; j < 4; ++j) { u32x2 wv; wv.x = cvtpk(v[j][0], v[j][1]); wv.y = cvtpk(v[j][2], v[j][3]); o8[64 * j] = wv; }
            if (lane < 16) SSQ0[(size_t)m * 16 + lane] = lane == 0 ? s : 0.f;
        }
    }
    SEAM(0);
    if (IN(1)) {
        pg8::Gemm g{XN, Wt_in_e, MTOK, 4096, DM}; pg8::StaticOrder S; S.init(MTOK, 4096, G, (int)blockIdx.x);
        EpiIn E{QKV, SSQ0, P.qkn_e, 0};
        _Pragma("unroll 1") for (int rep = 0; rep < REP_G1; ++rep) pg8::gemm_phase<EpiIn>(lds, g, S, E);
    }
    SEAM(1);
    if (IN(2)) {
        for (;;) {
            const int u = next_unit(ctl + 64, lds);
            if (u >= 2048) break;
            if (u < 512) { if (EN_B) { _Pragma("unroll 1") for (int rep = 0; rep < REP_B; ++rep) unit_B(P, (u >> 1) & 3, 2 + (u & 1), 63 - (u >> 3), lds); } }
            else if (u < 768) { const int v = u - 512; if (EN_B) { _Pragma("unroll 1") for (int rep = 0; rep < REP_B; ++rep) unit_B(P, v & 3, 1, 63 - (v >> 2), lds); } }
            else if (u < 1792) { if (EN_A) { _Pragma("unroll 1") for (int rep = 0; rep < REP_A; ++rep) unit_A(P, u - 768, lds); } }
            else { const int v = u - 1792; if (EN_B) { _Pragma("unroll 1") for (int rep = 0; rep < REP_B; ++rep) unit_B(P, v & 3, 0, 63 - (v >> 2), lds); } }
        }
    }
    SEAM(2);
    if (IN(3)) {
        pg8::Gemm g{MIXED, Wt_out_e, MTOK, DM, DM}; pg8::StaticOrder S; S.init(MTOK, DM, G, (int)blockIdx.x);
        EpiOut E{P.x, P.out, XN, SSQ1};
        _Pragma("unroll 1") for (int rep = 0; rep < REP_G2; ++rep) pg8::gemm_phase<EpiOut>(lds, g, S, E);
    }
    SEAM(3);
    if (IN(4)) {
        pg8::Gemm g{XN, Wt_in_o, MTOK, 4096, DM}; pg8::StaticOrder S; S.init(MTOK, 4096, G, (int)blockIdx.x);
        EpiIn E{QKV, SSQ1, P.qkn_o, 1};
        pg8::gemm_phase<EpiIn>(lds, g, S, E);
    }
    SEAM(4);
    if (IN(5)) {
        if (wave == 0) { for (int it = blockIdx.x; it < 256; it += G) compress_unit(P, it, lane); }
        else { for (int it = blockIdx.x * (NWAVES - 1) + wave - 1; it < 1024; it += G * (NWAVES - 1)) kmean_unit(P, it, lane); }
    }
    SEAM(5);
    if (IN(6)) {
        for (;;) {
            const int u = next_unit(ctl + 128, lds);
            if (u >= 2048) break;
            if (u < 512) { if (EN_C) { _Pragma("unroll 1") for (int rep = 0; rep < REP_C; ++rep) unit_C(P, (u >> 2) & 3, 4 + (u & 3), 31 - (u >> 4), lds); } }
            else if (u < 1536) { const int v = u - 512; if (EN_D) { _Pragma("unroll 1") for (int rep = 0; rep < REP_D; ++rep) unit_D(P, (v & 7) >> 1, v & 1, 127 - (v >> 3), lds); } }
            else { const int v = u - 1536; if (EN_C) { _Pragma("unroll 1") for (int rep = 0; rep < REP_C; ++rep) unit_C(P, (v >> 2) & 3, v & 3, 31 - (v >> 4), lds); } }
        }
    }
    SEAM(6);
    if (IN(7)) {
        pg8::Gemm g{MIXED, Wt_out_o, MTOK, DM, DM}; pg8::StaticOrder S; S.init(MTOK, DM, G, (int)blockIdx.x);
        EpiOut E{P.out, P.out, nullptr, nullptr};
        pg8::gemm_phase<EpiOut>(lds, g, S, E);
    }
#undef IN
#undef SEAM
}

extern "C" void kernel_launch(void* const* d_in, const int* in_sizes, int n_in, void* d_out, int out_size, void* d_ws, size_t ws_size, hipStream_t stream) {
    static int grid = 0;
    if (grid == 0) {
        if (n_in != 14 || in_sizes[0] != MTOK * DM || out_size != MTOK * DM || ws_size < WS_END) { fprintf(stderr, "kernel_launch: unexpected shapes (n_in %d, in0 %d, out %d, ws %zu)\n", n_in, n_in > 0 ? in_sizes[0] : -1, out_size, ws_size); grid = -1; return; }
        int dev = 0, cus = 0, per_cu = 0;
        hipGetDevice(&dev); hipDeviceGetAttribute(&cus, hipDeviceAttributeMultiprocessorCount, dev);
        if (hipFuncSetAttribute((const void*)mk_fwd, hipFuncAttributeMaxDynamicSharedMemorySize, LDS_BYTES) != hipSuccess) { fprintf(stderr, "kernel_launch: hipFuncSetAttribute failed\n"); grid = -1; return; }
        hipOccupancyMaxActiveBlocksPerMultiprocessor(&per_cu, (const void*)mk_fwd, NTHREADS, LDS_BYTES);
        (void)hipGetLastError();
        if (per_cu < 1) { fprintf(stderr, "kernel_launch: occupancy query says %d blocks per CU\n", per_cu); per_cu = 1; }
        grid = cus;
    }
    if (grid < 0) return;
    hipMemsetAsync((char*)d_ws + WS_CTL, 0, CTL_BYTES, stream);
    Params p{};
    p.x = (const float*)d_in[0]; p.ln_e = (const float*)d_in[1]; p.w_in_e = (const float*)d_in[2]; p.qkn_e = (const float*)d_in[3]; p.lam_e = (const float*)d_in[4];
    p.subln_e = (const float*)d_in[5]; p.w_out_e = (const float*)d_in[6]; p.ln_o = (const float*)d_in[7]; p.w_in_o = (const float*)d_in[8]; p.qkn_o = (const float*)d_in[9];
    p.phi_pe = (const float*)d_in[10]; p.phi_w1 = (const float*)d_in[11]; p.phi_w2 = (const float*)d_in[12]; p.w_out_o = (const float*)d_in[13];
    p.out = (float*)d_out; p.ws = (unsigned char*)d_ws;
#if MK_LAUNCHES == 1
    p.ph_lo = 0; p.ph_hi = 8;
    void* args[] = {&p};
    hipError_t e = hipLaunchCooperativeKernel((const void*)mk_fwd, dim3(grid), dim3(NTHREADS), args, LDS_BYTES, stream);
    if (e != hipSuccess) fprintf(stderr, "cooperative launch failed: %s (grid %d)\n", hipGetErrorString(e), grid);
#else
    for (int ph = 0; ph < 8; ++ph) { p.ph_lo = ph; p.ph_hi = ph + 1; hipLaunchKernelGGL(mk_fwd, dim3(grid), dim3(NTHREADS), LDS_BYTES, stream, p); }
#endif
}
```

```cpp
#include <hip/hip_runtime.h>
#include <hip/hip_cooperative_groups.h>
#include <cstdio>
#include <cstdint>
namespace cg = cooperative_groups;

#ifndef MK_LAUNCHES
#define MK_LAUNCHES 1
#endif

#ifndef EN_A
#define EN_A 1
#endif
#ifndef EN_B
#define EN_B 1
#endif
#ifndef EN_C
#define EN_C 1
#endif
#ifndef EN_D
#define EN_D 1
#endif
#ifndef REP_A
#define REP_A 1
#endif
#ifndef REP_B
#define REP_B 1
#endif
#ifndef REP_C
#define REP_C 1
#endif
#ifndef REP_D
#define REP_D 1
#endif
#ifndef REP_G1
#define REP_G1 1
#endif
#ifndef REP_G2
#define REP_G2 1
#endif
#ifndef REP_P0
#define REP_P0 1
#endif
#ifndef REP_QK
#define REP_QK 1
#endif
#ifndef REP_SM
#define REP_SM 1
#endif
#ifndef REP_PV
#define REP_PV 1
#endif
#ifndef REP_P5
#define REP_P5 1
#endif
#ifndef PROBE_ID
#define PROBE_ID 1
#endif
__device__ __forceinline__ unsigned long long tp_now() { return __builtin_amdgcn_s_memrealtime(); }
struct TP { unsigned long long t0, acc; };
#define TP_BEGIN(id) do { if (PROBE_ID == (id)) { tp.t0 = tp_now(); } } while (0)
#define TP_END(id) do { if (PROBE_ID == (id)) { tp.acc += tp_now() - tp.t0; } } while (0)
#define LAS __attribute__((address_space(3)))
typedef unsigned short bf16_t;
typedef short bf16x8 __attribute__((ext_vector_type(8)));
typedef short s16x4 __attribute__((ext_vector_type(4)));
typedef float f32x4 __attribute__((ext_vector_type(4)));
typedef float f32x16 __attribute__((ext_vector_type(16)));
typedef unsigned u32x4 __attribute__((ext_vector_type(4)));
typedef unsigned u32x2 __attribute__((ext_vector_type(2)));
typedef float f32x2_t __attribute__((ext_vector_type(2)));
typedef __bf16 bf16x2_t __attribute__((ext_vector_type(2)));

constexpr int BATCH = 4, SEQ = 8192, DM = 1024, MTOK = BATCH * SEQ, PQ = 4096;
constexpr int ODD_N = 3864;
constexpr float EPS = 1e-6f, LOG2E = 1.4426950408889634f, C2 = 0.125f * LOG2E;
constexpr float THR = 8.0f;
constexpr int NWAVES = 8, NTHREADS = 512;

constexpr size_t MiB = 1u << 20;
constexpr size_t WS_CTL = 0, CTL_BYTES = 32768;
constexpr size_t WS_WIN_E = 2 * MiB, WS_WOUT_E = 10 * MiB, WS_WIN_O = 12 * MiB, WS_WOUT_O = 20 * MiB;
constexpr size_t WS_W1T = 22 * MiB, WS_W2T = 23 * MiB, WS_BIAS1 = 23 * MiB + 65536, WS_KMEAN = 23 * MiB + 131072;
constexpr size_t WS_KCMP = 24 * MiB, WS_VCMP = 24 * MiB + 524288;
constexpr size_t WS_SSQ0 = 26 * MiB, WS_SSQ1 = 28 * MiB;
constexpr size_t WS_XN = 32 * MiB, WS_MIXED = 96 * MiB, WS_QKV = 160 * MiB, WS_END = 416 * MiB;

constexpr int RING_BYTES = 131072, LDSCTL_OFF = 143360, LDS_BYTES = 147456;

__device__ __forceinline__ unsigned f2bf(float f) { unsigned u = __builtin_bit_cast(unsigned, f); return (u + 0x7fffu + ((u >> 16) & 1u)) >> 16; }
__device__ __forceinline__ unsigned pk2(float lo, float hi) { return f2bf(lo) | (f2bf(hi) << 16); }
__device__ __forceinline__ float bf2f(unsigned b) { return __builtin_bit_cast(float, b << 16); }
__device__ __forceinline__ unsigned cvtpk(float lo, float hi) { f32x2_t v = {lo, hi}; bf16x2_t b = __builtin_convertvector(v, bf16x2_t); return __builtin_bit_cast(unsigned, b); }
__device__ __forceinline__ int crow(int r, int hi) { return (r & 3) + 8 * (r >> 2) + 4 * hi; }
__device__ __forceinline__ float wave_sum(float v) {
#pragma unroll
    for (int o = 1; o < 64; o <<= 1) v += __shfl_xor(v, o);
    return v;
}
__device__ __forceinline__ float swap_add(float v) { auto rr = __builtin_amdgcn_permlane32_swap(__float_as_uint(v), __float_as_uint(v), false, false); return __uint_as_float(rr[0]) + __uint_as_float(rr[1]); }
__device__ __forceinline__ float swap_max(float v) { auto rr = __builtin_amdgcn_permlane32_swap(__float_as_uint(v), __float_as_uint(v), false, false); return fmaxf(__uint_as_float(rr[0]), __uint_as_float(rr[1])); }
__device__ __forceinline__ void glds16(const void* g, LAS void* l) {
    unsigned keep; const unsigned dst = (unsigned)__builtin_amdgcn_readfirstlane((int)(unsigned)(uintptr_t)l);
    asm volatile("s_mov_b32 %0, m0\n\ts_mov_b32 m0, %2\n\ts_nop 0\n\tglobal_load_lds_dwordx4 %1, off\n\ts_mov_b32 m0, %0" : "=&s"(keep) : "v"(g), "s"(dst) : "memory");
}
#define LDS_WAIT() asm volatile("s_waitcnt lgkmcnt(0)" ::: "memory")
#define VM_WAIT() asm volatile("s_waitcnt vmcnt(0)" ::: "memory")

namespace pg8 {
constexpr int BM = 256, BK = 64, HALF = 128, HTB = HALF * BK * 2, NXCD = 8, WGM = 8;
__host__ __device__ __forceinline__ int lds_byte(int r, int c) { const int st = (r >> 4) * 2 + (c >> 5), rr = r & 15, cc = c & 31, ob = rr * 64 + cc * 2; return st * 1024 + (ob ^ (((ob >> 9) & 1) << 5)); }
__host__ __device__ __forceinline__ void stage_rc(int b, int& R, int& C) { const int st = b / 1024, sb = b % 1024, swz = sb ^ (((sb >> 9) & 1) << 5); R = (st >> 1) * 16 + swz / 64; C = (st & 1) * 32 + (swz % 64) / 2; }
__host__ __device__ __forceinline__ int perm32(int rho) { const int n = rho >> 4, i = rho & 15; return 8 * (i >> 2) + 4 * n + (i & 3); }
struct Unit { int pm, pn; };
struct Gemm { const bf16_t* A; const bf16_t* Bt; int M, N, K; };
struct StaticOrder {
    int nM, nN, nwg, G, c, reps, ipw;
    __device__ void init(int M, int N, int G_, int c_, int reps_ = 1) { nM = M / BM; nN = N / BM; nwg = nM * nN; G = G_; c = c_; reps = reps_; ipw = (nwg + G - 1) / G; }
    __device__ bool next(int i, Unit& u) const {
        if (i >= reps * ipw) return false;
        const long L = (long)(i % ipw) * G + c; if (L >= nwg) return false;
        int wgid = (int)L; { const int q = nwg / NXCD, r = nwg % NXCD, xcd = wgid % NXCD, off = wgid / NXCD; wgid = (xcd < r ? xcd * (q + 1) : r * (q + 1) + (xcd - r) * q) + off; }
        const int nig = WGM * nN, gid = wgid / nig, fm = gid * WGM, gsz = (nM - fm) < WGM ? (nM - fm) : WGM;
        u.pm = fm + ((wgid % nig) % gsz); u.pn = (wgid % nig) / gsz; return true;
    }
};

template <class Epi>
__device__ __forceinline__ void gemm_phase(LAS unsigned char* lds, const Gemm g, const StaticOrder& S, const Epi& E) {
    const int tid = threadIdx.x, wid = __builtin_amdgcn_readfirstlane(tid >> 6), lane = tid & 63, wr = wid >> 2, wc = wid & 3, fr = lane & 15, fq = lane >> 4;
    const int K = g.K, nt = K / BK;
    unsigned voffA[2], voffB[2];
#pragma unroll
    for (int i = 0; i < 2; ++i) { int R, C; stage_rc(tid * 16 + i * 8192, R, C); const int Rb = Epi::PERM ? ((R & ~31) + perm32(R & 31)) : R;
        voffA[i] = (unsigned)(R * K + C) * 2u; voffB[i] = (unsigned)(Rb * K + C) * 2u; }
    const size_t kstep = (size_t)(BK * 2);
    const size_t hstep = (size_t)HALF * K * 2;
    const size_t tstep = 2 * hstep;
    const unsigned ldsw = (unsigned)wid * 1024u;
    const int aoff = lds_byte(wr * 64 + fr, fq * 8), boff = lds_byte(wc * 32 + fr, fq * 8);
#define PG8_SA(b, h) (((b) * 2 + (h)) * HTB)
#define PG8_SB(b, h) ((4 + (b) * 2 + (h)) * HTB)
#define PG8_STAGE(bufoff, gbase, voff) do { _Pragma("unroll") for (int _i = 0; _i < 2; ++_i) \
        __builtin_amdgcn_global_load_lds((const unsigned*)((const char*)(gbase) + (voff)[_i]), (LAS unsigned*)(lds + (bufoff) + ldsw + _i * 8192), 16, 0, 0); } while (0)
#define PG8_LDA(dst, b, h) do { _Pragma("unroll") for (int m = 0; m < 4; ++m) _Pragma("unroll") for (int k = 0; k < 2; ++k) dst[m][k] = *(const LAS bf16x8*)(lds + PG8_SA(b, h) + aoff + m * 2048 + k * 1024); } while (0)
#define PG8_LDB(dst, b, h) do { _Pragma("unroll") for (int n = 0; n < 2; ++n) _Pragma("unroll") for (int k = 0; k < 2; ++k) dst[n][k] = *(const LAS bf16x8*)(lds + PG8_SB(b, h) + boff + n * 2048 + k * 1024); } while (0)
#define PG8_MMA(ai, bj, At, Bt) do { __builtin_amdgcn_s_setprio(1); _Pragma("unroll") for (int m = 0; m < 4; ++m) _Pragma("unroll") for (int n = 0; n < 2; ++n) _Pragma("unroll") for (int k = 0; k < 2; ++k) \
        acc[ai][bj][m][n] = __builtin_amdgcn_mfma_f32_16x16x32_bf16(Bt[n][k], At[m][k], acc[ai][bj][m][n], 0, 0, 0); __builtin_amdgcn_s_setprio(0); } while (0)
#define PG8_WAIT_V(n) asm volatile("s_waitcnt vmcnt(" #n ")" ::: "memory")
#define PG8_WAIT_L(n) asm volatile("s_waitcnt lgkmcnt(" #n ")" ::: "memory")
#define PG8_BAR __builtin_amdgcn_s_barrier()
#define PG8_SCHED __builtin_amdgcn_sched_barrier(0)
    Unit cur, nxt; int ui = 0;
    if (!S.next(0, cur)) return;
    f32x4 acc[2][2][4][2];
#pragma unroll
    for (int a = 0; a < 2; ++a)
#pragma unroll
        for (int b = 0; b < 2; ++b)
#pragma unroll
            for (int m = 0; m < 4; ++m)
#pragma unroll
                for (int n = 0; n < 2; ++n) acc[a][b][m][n] = (f32x4){0.f, 0.f, 0.f, 0.f};
    bf16x8 At[4][2], B0[2][2], B1[2][2];
    const char* cA = (const char*)g.A + (size_t)cur.pm * tstep; const char* cB = (const char*)g.Bt + (size_t)cur.pn * tstep;
    PG8_STAGE(PG8_SB(0, 0), cB, voffB); PG8_STAGE(PG8_SB(0, 1), cB + hstep, voffB); PG8_STAGE(PG8_SA(0, 0), cA, voffA); PG8_STAGE(PG8_SA(0, 1), cA + hstep, voffA);
    if (wr == 1) PG8_BAR;
    PG8_WAIT_V(2); PG8_BAR;
    PG8_STAGE(PG8_SB(1, 0), cB + kstep, voffB); PG8_STAGE(PG8_SA(1, 0), cA + kstep, voffA); PG8_STAGE(PG8_SB(1, 1), cB + hstep + kstep, voffB);
    PG8_WAIT_V(6); PG8_BAR;
    for (;;) {
        const bool has_next = S.next(ui + 1, nxt);
        const char* nA = has_next ? (const char*)g.A + (size_t)nxt.pm * tstep : cA; const char* nB = has_next ? (const char*)g.Bt + (size_t)nxt.pn * tstep : cB;
        for (int t = 0; t < nt; t += 2) {
            const bool last = (t == nt - 2);
            const char* a1 = cA + (size_t)(t + 1) * kstep;
            const char* a2 = last ? nA : cA + (size_t)(t + 2) * kstep; const char* b2 = last ? nB : cB + (size_t)(t + 2) * kstep;
            const char* a3 = a2 + kstep; const char* b3 = b2 + kstep;
            PG8_LDB(B0, 0, 0); PG8_LDB(B1, 0, 1); PG8_SCHED; PG8_LDA(At, 0, 0); PG8_STAGE(PG8_SA(1, 1), a1 + hstep, voffA);
            PG8_WAIT_V(8); PG8_WAIT_L(0); PG8_BAR; PG8_MMA(0, 0, At, B0); PG8_MMA(0, 1, At, B1); PG8_BAR; PG8_SCHED;
            PG8_LDA(At, 0, 1); PG8_STAGE(PG8_SB(0, 0), b2, voffB); PG8_STAGE(PG8_SB(0, 1), b2 + hstep, voffB); PG8_STAGE(PG8_SA(0, 0), a2, voffA);
            PG8_WAIT_V(8); PG8_WAIT_L(0); PG8_BAR; PG8_MMA(1, 0, At, B0); PG8_MMA(1, 1, At, B1); PG8_BAR; PG8_SCHED;
            PG8_LDB(B0, 1, 0); PG8_LDB(B1, 1, 1); PG8_SCHED; PG8_LDA(At, 1, 0); PG8_STAGE(PG8_SA(0, 1), a2 + hstep, voffA);
            PG8_WAIT_V(8); PG8_WAIT_L(0); PG8_BAR; PG8_MMA(0, 0, At, B0); PG8_MMA(0, 1, At, B1); PG8_BAR; PG8_SCHED;
            PG8_LDA(At, 1, 1); PG8_STAGE(PG8_SB(1, 0), b3, voffB); PG8_STAGE(PG8_SB(1, 1), b3 + hstep, voffB); PG8_STAGE(PG8_SA(1, 0), a3, voffA);
            PG8_WAIT_V(8); PG8_WAIT_L(0); PG8_BAR; PG8_MMA(1, 0, At, B0); PG8_MMA(1, 1, At, B1); PG8_BAR; PG8_SCHED;
        }
        if (wr == 0) PG8_BAR;
        E(acc, cur, wr, wc, fr, fq);
        if (!has_next) break;
#pragma unroll
        for (int a = 0; a < 2; ++a)
#pragma unroll
            for (int b = 0; b < 2; ++b)
#pragma unroll
                for (int m = 0; m < 4; ++m)
#pragma unroll
                    for (int n = 0; n < 2; ++n) acc[a][b][m][n] = (f32x4){0.f, 0.f, 0.f, 0.f};
        cur = nxt; cA = nA; cB = nB; ++ui;
        if (wr == 1) PG8_BAR;
    }
    PG8_WAIT_V(0);
    PG8_BAR;
#undef PG8_SA
#undef PG8_SB
#undef PG8_STAGE
#undef PG8_LDA
#undef PG8_LDB
#undef PG8_MMA
#undef PG8_WAIT_V
#undef PG8_WAIT_L
#undef PG8_BAR
#undef PG8_SCHED
}
}


#define XB_TMO      128
#define XB_XCNT(j)  (256  + 64 * (j))
#define XB_XSUB(j)  (1280 + 64 * (j))
#define XB_XGEN(j)  (2304 + 64 * (j))
#define XB_TOP      3328
#define XB_TOPGEN   3392
#define XCD_BAR_WORDS 3456
#define XB_SPIN_CAP (1u << 18)
__device__ __forceinline__ unsigned xb_ld(unsigned* p)              { return __hip_atomic_load(p, __ATOMIC_RELAXED, __HIP_MEMORY_SCOPE_AGENT); }
__device__ __forceinline__ unsigned xb_add(unsigned* p, unsigned v) { return __hip_atomic_fetch_add(p, v, __ATOMIC_RELAXED, __HIP_MEMORY_SCOPE_AGENT); }
__device__ __forceinline__ unsigned xb_xcc_id() { return (unsigned)__builtin_amdgcn_s_getreg((3 << 11) | 20) & 0xFu; }
#define XB_SPIN(cond, bar) do { unsigned _sp = 0; while (cond) { __builtin_amdgcn_s_sleep(1); \
    if ((++_sp & 255u) == 0u) { if (xb_ld(&(bar)[XB_TMO])) break; if (_sp > XB_SPIN_CAP) { atomicAdd(&(bar)[XB_TMO], 1u); break; } } } } while (0)
struct XcdBarrier { unsigned* bar; unsigned x; volatile LAS unsigned* st; };
__device__ __forceinline__ XcdBarrier xcd_barrier_post(unsigned* bar, volatile LAS unsigned* st) {
    XcdBarrier b; b.bar = bar; b.x = xb_xcc_id(); b.st = st;
    if (threadIdx.x == 0) (void)xb_add(&bar[XB_XCNT(b.x)], 1u);
    return b;
}
__device__ __forceinline__ void xcd_barrier_complete(unsigned* bar, unsigned x, unsigned& nloc, unsigned& nx) {
    const unsigned G = gridDim.x * gridDim.y * gridDim.z;
    unsigned sum, cnt, mine, sp = 0u;
    for (;;) {
        sum = 0u; cnt = 0u; mine = 0u;
#pragma unroll
        for (unsigned j = 0; j < 16; ++j) { const unsigned c = xb_ld(&bar[XB_XCNT(j)]); sum += c; cnt += (c > 0u) ? 1u : 0u; mine = (j == x) ? c : mine; }
        if (sum == G) break;
        __builtin_amdgcn_s_sleep(1);
        if ((++sp & 255u) == 0u) { if (xb_ld(&bar[XB_TMO])) break; if (sp > XB_SPIN_CAP) { atomicAdd(&bar[XB_TMO], 1u); break; } }
    }
    nloc = mine > 0u ? mine : 1u; nx = cnt > 0u ? cnt : 1u;
}
__device__ __forceinline__ void xcd_barrier(const XcdBarrier& b) {
    asm volatile("s_waitcnt vmcnt(0)" ::: "memory");
    __syncthreads();
    if (threadIdx.x == 0) {
        unsigned* bar = b.bar;
        __builtin_amdgcn_s_waitcnt(0);
        unsigned nloc = b.st[0], nx = b.st[1];
        if (nloc == 0u) { xcd_barrier_complete(bar, b.x, nloc, nx); b.st[0] = nloc; b.st[1] = nx; }
        const unsigned old = xb_add(&bar[XB_XSUB(b.x)], 1u);
        const unsigned gen = old / nloc;
        if (old + 1u == (gen + 1u) * nloc) {
            __builtin_amdgcn_fence(__ATOMIC_RELEASE, "agent");
            asm volatile("s_waitcnt vmcnt(0)" ::: "memory");
            const unsigned og = xb_add(&bar[XB_TOP], 1u);
            const unsigned tg = og / nx;
            if (og + 1u == (tg + 1u) * nx) xb_add(&bar[XB_TOPGEN], 1u);
            else XB_SPIN(xb_ld(&bar[XB_TOPGEN]) == tg, bar);
            __builtin_amdgcn_fence(__ATOMIC_ACQUIRE, "agent");
            xb_add(&bar[XB_XGEN(b.x)], 1u);
            asm volatile("s_waitcnt vmcnt(0)" ::: "memory");
        } else {
            XB_SPIN(xb_ld(&bar[XB_XGEN(b.x)]) == gen, bar);
            __builtin_amdgcn_fence(__ATOMIC_ACQUIRE, "agent");
            asm volatile("s_waitcnt vmcnt(0)" ::: "memory");
        }
    }
    __syncthreads();
}

struct Params {
    const float* x; const float* ln_e; const float* w_in_e; const float* qkn_e; const float* lam_e; const float* subln_e; const float* w_out_e;
    const float* ln_o; const float* w_in_o; const float* qkn_o; const float* phi_pe; const float* phi_w1; const float* phi_w2; const float* w_out_o;
    float* out; unsigned char* ws;
    int ph_lo, ph_hi;
};

enum { OP_COPY = 0, OP_NORM = 1, OP_SILU = 2, OP_SIGM = 3 };
__device__ __forceinline__ void group_op(int layer, int G, const float* qkn, int& type, const float*& gain, float& scale) {
    type = OP_COPY; gain = qkn; scale = 1.f;
    if (layer == 0) {
        const int s = G >> 3;
        if (s == 0) { type = OP_NORM; gain = qkn; scale = C2; }
        else if (s == 1) { type = OP_NORM; gain = qkn + 64; }
        else if (s == 3 || s == 7) type = OP_SILU;
        else if (s == 4) { type = OP_NORM; gain = qkn + 128; scale = C2; }
        else if (s == 5) { type = OP_NORM; gain = qkn + 192; }
    } else {
        if (G < 8) { type = OP_NORM; gain = qkn; scale = C2; }
        else if (G < 16) { type = OP_NORM; gain = qkn + 64; }
        else if (G < 24) type = OP_COPY;
        else if (G < 32) type = OP_SILU;
        else if (G < 40) { type = OP_NORM; gain = qkn + 128; scale = C2; }
        else if (G < 44) type = OP_COPY;
        else if (G < 46) { type = OP_NORM; gain = qkn + 256; }
        else if (G < 48) type = OP_COPY;
        else if (G < 50) { type = OP_NORM; gain = qkn + 320; }
        else if (G < 52) type = OP_COPY;
        else if (G < 60) type = OP_SILU;
        else if (G == 60) type = OP_SIGM;
    }
}

struct EpiIn {
    static constexpr bool PERM = true;
    bf16_t* O; const float* ssq; const float* qkn; int layer;
    __device__ __forceinline__ void operator()(const f32x4 (&acc)[2][2][4][2], const pg8::Unit& u, int wr, int wc, int fr, int fq) const {
        int type; const float* gain; float scale; group_op(layer, u.pn * 4 + wc, qkn, type, gain, scale);
        f32x4 gv[2][2];
#pragma unroll
        for (int bj = 0; bj < 2; ++bj)
#pragma unroll
            for (int n = 0; n < 2; ++n) gv[bj][n] = (type == OP_NORM) ? *(const f32x4*)(gain + 32 * bj + 8 * fq + 4 * n) * scale : (f32x4){1.f, 1.f, 1.f, 1.f};
        float sq[2][4];
#pragma unroll
        for (int ai = 0; ai < 2; ++ai)
#pragma unroll
            for (int m = 0; m < 4; ++m) sq[ai][m] = ssq[u.pm * 256 + ai * 128 + wr * 64 + m * 16 + fr];
#pragma unroll
        for (int ai = 0; ai < 2; ++ai)
#pragma unroll
            for (int m = 0; m < 4; ++m) {
                const int row = u.pm * 256 + ai * 128 + wr * 64 + m * 16 + fr;
                const float rstd = __builtin_amdgcn_rsqf(sq[ai][m] * (1.0f / DM) + EPS);
                f32x4 v[2][2];
#pragma unroll
                for (int bj = 0; bj < 2; ++bj)
#pragma unroll
                    for (int n = 0; n < 2; ++n) v[bj][n] = acc[ai][bj][m][n] * rstd;
                if (type == OP_NORM) {
                    float ss = 0.f;
#pragma unroll
                    for (int bj = 0; bj < 2; ++bj)
#pragma unroll
                        for (int n = 0; n < 2; ++n) { const f32x4 t = v[bj][n]; ss += (t[0] * t[0] + t[1] * t[1]) + (t[2] * t[2] + t[3] * t[3]); }
                    ss += __shfl_xor(ss, 16); ss += __shfl_xor(ss, 32);
                    const float r = __builtin_amdgcn_rsqf(ss * (1.0f / 64.0f) + EPS);
#pragma unroll
                    for (int bj = 0; bj < 2; ++bj)
#pragma unroll
                        for (int n = 0; n < 2; ++n) v[bj][n] = v[bj][n] * r * gv[bj][n];
                } else if (type == OP_SILU || type == OP_SIGM) {
#pragma unroll
                    for (int bj = 0; bj < 2; ++bj)
#pragma unroll
                        for (int n = 0; n < 2; ++n)
#pragma unroll
                            for (int e = 0; e < 4; ++e) { const float t = v[bj][n][e]; const float sg = 1.0f / (1.0f + __builtin_amdgcn_exp2f(-t * LOG2E)); v[bj][n][e] = (type == OP_SILU) ? t * sg : sg; }
                }
                bf16_t* rowp = O + (size_t)row * PQ + u.pn * 256 + 64 * wc + 8 * fq;
#pragma unroll
                for (int bj = 0; bj < 2; ++bj) { u32x4 w; w.x = cvtpk(v[bj][0][0], v[bj][0][1]); w.y = cvtpk(v[bj][0][2], v[bj][0][3]); w.z = cvtpk(v[bj][1][0], v[bj][1][1]); w.w = cvtpk(v[bj][1][2], v[bj][1][3]);
                    *(u32x4*)(rowp + 32 * bj) = w; }
            }
    }
};

struct EpiOut {
    static constexpr bool PERM = false;
    const float* res; float* out; bf16_t* xn; float* ssq;
    __device__ __forceinline__ void operator()(const f32x4 (&acc)[2][2][4][2], const pg8::Unit& u, int wr, int wc, int fr, int fq) const {
#pragma unroll
        for (int ai = 0; ai < 2; ++ai) {
            f32x4 rv[4][2][2];
#pragma unroll
            for (int m = 0; m < 4; ++m)
#pragma unroll
                for (int bj = 0; bj < 2; ++bj)
#pragma unroll
                    for (int n = 0; n < 2; ++n) rv[m][bj][n] = *(const f32x4*)(res + (size_t)(u.pm * 256 + ai * 128 + wr * 64 + m * 16 + fr) * DM + u.pn * 256 + 128 * bj + 32 * wc + 16 * n + 4 * fq);
            asm volatile("" ::: "memory");
#pragma unroll
            for (int m = 0; m < 4; ++m) {
                const int row = u.pm * 256 + ai * 128 + wr * 64 + m * 16 + fr; float ss = 0.f;
#pragma unroll
                for (int bj = 0; bj < 2; ++bj)
#pragma unroll
                    for (int n = 0; n < 2; ++n) {
                        const size_t off = (size_t)row * DM + u.pn * 256 + 128 * bj + 32 * wc + 16 * n + 4 * fq;
                        const f32x4 o = rv[m][bj][n] + acc[ai][bj][m][n];
                        *(f32x4*)(out + off) = o;
                        if (xn) { u32x2 w; w.x = cvtpk(o[0], o[1]); w.y = cvtpk(o[2], o[3]); *(u32x2*)(xn + off) = w; ss += (o[0] * o[0] + o[1] * o[1]) + (o[2] * o[2] + o[3] * o[3]); }
                    }
                if (xn) { ss += __shfl_xor(ss, 16); ss += __shfl_xor(ss, 32); if (fq == 0) atomicAdd(ssq + row, ss); }
            }
            asm volatile("" ::: "memory");
        }
    }
};

__device__ __forceinline__ int physrow(int L) { const int Lt = L & 255; return (L - Lt) + 128 * ((Lt >> 5) & 1) + 32 * (Lt >> 6) + (Lt & 31); }
__device__ __forceinline__ void transpose_item(const float* W, int K, int N, bf16_t* WT, bool permute, const float* g, LAS float* scr, int item, int lane, int nblk) {
    const int kb = item / nblk, nb = item % nblk, k0 = 64 * kb, n0 = 32 * nb;
    const int n = n0 + (lane & 31);
#pragma unroll 8
    for (int i = 0; i < 32; ++i) { const int kk = 2 * i + (lane >> 5); float v = (n < N) ? W[(size_t)(k0 + kk) * N + n] : 0.f; if (g) v *= g[k0 + kk]; scr[kk * 33 + (lane & 31)] = v; }
    LDS_WAIT();
    const int c = lane & 7; const int prow0 = permute ? physrow(n0) : n0;
#pragma unroll
    for (int j = 0; j < 4; ++j) { const int nn = (lane >> 3) + 8 * j; const LAS float* s = scr + (8 * c) * 33 + nn;
        u32x4 o; o.x = pk2(s[0 * 33], s[1 * 33]); o.y = pk2(s[2 * 33], s[3 * 33]); o.z = pk2(s[4 * 33], s[5 * 33]); o.w = pk2(s[6 * 33], s[7 * 33]);
        *(u32x4*)(WT + (size_t)(prow0 + nn) * K + k0 + 8 * c) = o; }
    LDS_WAIT();
}

__device__ __forceinline__ int tile_sw(int row) { return (((row >> 1) & 1) << 2) | (((row >> 3) & 1) << 1) | ((row >> 2) & 1); }
__device__ __forceinline__ s16x4 vtr(const LAS char* p) { return __builtin_bit_cast(s16x4, __builtin_amdgcn_ds_read_tr16_b64_v4i16((LAS s16x4*)p)); }

__device__ __forceinline__ void qk_tile(f32x16& p0, f32x16& p1, const LAS char* Kt, const bf16x8 (&qr)[4], float cb, float stepk, int r32, int hi) {
    f32x16 c0, c1;
    const float cbh = cb + stepk * (float)(4 * hi), cbh1 = cbh + stepk * 32.f;
#pragma unroll
    for (int r = 0; r < 16; ++r) { c0[r] = __builtin_fmaf(stepk, (float)((r & 3) + 8 * (r >> 2)), cbh); c1[r] = __builtin_fmaf(stepk, (float)((r & 3) + 8 * (r >> 2)), cbh1); }
    const LAS char* kb = Kt + r32 * 128; const int sw = tile_sw(r32);
    bf16x8 kf[8];
#pragma unroll
    for (int d0 = 0; d0 < 4; ++d0) { const int off = ((2 * d0 + hi) ^ sw) << 4; kf[2 * d0] = *(const LAS bf16x8*)(kb + off); kf[2 * d0 + 1] = *(const LAS bf16x8*)(kb + 4096 + off); }
    p0 = __builtin_amdgcn_mfma_f32_32x32x16_bf16(kf[0], qr[0], c0, 0, 0, 0); p1 = __builtin_amdgcn_mfma_f32_32x32x16_bf16(kf[1], qr[0], c1, 0, 0, 0);
#pragma unroll
    for (int d0 = 1; d0 < 4; ++d0) { p0 = __builtin_amdgcn_mfma_f32_32x32x16_bf16(kf[2 * d0], qr[d0], p0, 0, 0, 0); p1 = __builtin_amdgcn_mfma_f32_32x32x16_bf16(kf[2 * d0 + 1], qr[d0], p1, 0, 0, 0); }
}
__device__ __forceinline__ void mask_tile(f32x16& p0, f32x16& p1, int dq0, int pstride, int dmin, int dmaxe, int hi) {
    const float NEG = -INFINITY;
#pragma unroll
    for (int r = 0; r < 16; ++r) {
        const int d = dq0 - pstride * crow(r, hi), d1 = d - 32 * pstride;
        if (d < dmin || d > dmaxe) p0[r] = NEG;
        if (d1 < dmin || d1 > dmaxe) p1[r] = NEG;
    }
}
__device__ __forceinline__ float rowmax32(const f32x16& p0, const f32x16& p1) {
    float a = fmaxf(p0[0], p1[0]);
#pragma unroll
    for (int r = 1; r < 16; ++r) a = fmaxf(fmaxf(a, p0[r]), p1[r]);
    return swap_max(a);
}
__device__ __forceinline__ void pack_p(bf16x8 (&pw)[4], const f32x16& p0, const f32x16& p1) {
    u32x4 a, b, c, d;
    a.x = cvtpk(p0[0], p0[1]); a.y = cvtpk(p0[2], p0[3]); a.z = cvtpk(p0[4], p0[5]); a.w = cvtpk(p0[6], p0[7]);
    b.x = cvtpk(p0[8], p0[9]); b.y = cvtpk(p0[10], p0[11]); b.z = cvtpk(p0[12], p0[13]); b.w = cvtpk(p0[14], p0[15]);
    c.x = cvtpk(p1[0], p1[1]); c.y = cvtpk(p1[2], p1[3]); c.z = cvtpk(p1[4], p1[5]); c.w = cvtpk(p1[6], p1[7]);
    d.x = cvtpk(p1[8], p1[9]); d.y = cvtpk(p1[10], p1[11]); d.z = cvtpk(p1[12], p1[13]); d.w = cvtpk(p1[14], p1[15]);
    pw[0] = __builtin_bit_cast(bf16x8, a); pw[1] = __builtin_bit_cast(bf16x8, b); pw[2] = __builtin_bit_cast(bf16x8, c); pw[3] = __builtin_bit_cast(bf16x8, d);
}
template <int NDB>
__device__ __forceinline__ void pv_tile(f32x16 (&oT)[NDB], const LAS char* Vt, const bf16x8 (&pw)[4], int lane) {
    const int hi = lane >> 5, q = (lane & 15) >> 2, p = lane & 3, cl = 2 * ((lane >> 4) & 1) + (p >> 1);
    const LAS char* vb = Vt + (4 * hi + q) * 128 + (p & 1) * 8;
    const int s0 = ((q >> 1) << 2) | hi;
#pragma unroll
    for (int db = 0; db < NDB; ++db)
#pragma unroll
        for (int ks = 0; ks < 4; ++ks) {
            const int c0 = ((4 * (db & 1) + cl) ^ s0) << 4, c1 = ((4 * (db & 1) + cl) ^ (s0 | 2)) << 4;
            const s16x4 lo = vtr(vb + (db >> 1) * 8192 + ks * 2048 + c0), hh = vtr(vb + (db >> 1) * 8192 + ks * 2048 + 1024 + c1);
            const bf16x8 vf = (bf16x8){lo[0], lo[1], lo[2], lo[3], hh[0], hh[1], hh[2], hh[3]};
            oT[db] = __builtin_amdgcn_mfma_f32_32x32x16_bf16(vf, pw[ks], oT[db], 0, 0, 0);
        }
}
template <int NDB>
__device__ __forceinline__ void attn_tile(const LAS char* Kt, const LAS char* Vt, const bf16x8 (&qr)[4], f32x16 (&oT)[NDB], float rref, float& lsum,
                                          float cbase, float stepk, bool emask, int dq0, int pstride, int dmin, int dmaxe, int lane) {
    const int r32 = lane & 31, hi = lane >> 5;
    f32x16 p0, p1;
#if REP_QK > 1
    qk_tile(p0, p1, Kt, qr, cbase - rref, stepk, r32, hi);
    asm volatile("" : "+v"(p0), "+v"(p1));
    { f32x16 t0, t1; qk_tile(t0, t1, Kt, qr, cbase - rref, stepk, r32, hi); asm volatile("" :: "v"(t0), "v"(t1)); }
#else
    qk_tile(p0, p1, Kt, qr, cbase - rref, stepk, r32, hi);
#endif
    if (emask) { asm volatile("" ::: "memory"); mask_tile(p0, p1, dq0, pstride, dmin, dmaxe, hi); }
#if REP_SM > 1
    { f32x16 t0 = p0, t1 = p1; asm volatile("" : "+v"(t0), "+v"(t1)); float s2 = 0.f;
#pragma unroll
      for (int r = 0; r < 16; ++r) { t0[r] = __builtin_amdgcn_exp2f(t0[r]); t1[r] = __builtin_amdgcn_exp2f(t1[r]); s2 += t0[r] + t1[r]; }
      bf16x8 pw2[4]; pack_p(pw2, t0, t1); asm volatile("" :: "v"(pw2[0]), "v"(pw2[1]), "v"(pw2[2]), "v"(pw2[3]), "v"(s2)); }
#endif
    float s = 0.f;
#pragma unroll
    for (int r = 0; r < 16; ++r) { p0[r] = __builtin_amdgcn_exp2f(p0[r]); p1[r] = __builtin_amdgcn_exp2f(p1[r]); s += p0[r] + p1[r]; }
    lsum += s;
    bf16x8 pw[4]; pack_p(pw, p0, p1);
    pv_tile<NDB>(oT, Vt, pw, lane);
#if REP_PV > 1
    { bf16x8 pn[4];
#pragma unroll
      for (int k = 0; k < 4; ++k) { u32x4 t = __builtin_bit_cast(u32x4, pw[k]); t.x ^= 0x80008000u; t.y ^= 0x80008000u; t.z ^= 0x80008000u; t.w ^= 0x80008000u; pn[k] = __builtin_bit_cast(bf16x8, t); }
      pv_tile<NDB>(oT, Vt, pn, lane); asm volatile("" ::: "memory"); pv_tile<NDB>(oT, Vt, pw, lane); }
#endif
}

__device__ __forceinline__ void issue_piece(const bf16_t* colbase, size_t pitch, int tok, LAS char* buf, int i, int lane) {
    glds16(colbase + (size_t)tok * pitch + (((lane & 7) ^ tile_sw(8 * i + (lane >> 3))) << 3), buf + i * 1024);
}
__device__ __forceinline__ int clampi(int v, int lo, int hi) { return v < lo ? lo : (v > hi ? hi : v); }

template <int NDB>
__device__ __forceinline__ void store_rows(const f32x16 (&o)[NDB], const bf16_t* zrow, bf16_t* orow, int hi) {
#pragma unroll
    for (int db = 0; db < NDB; ++db)
#pragma unroll
        for (int q4 = 0; q4 < 4; ++q4) {
            const int d = 32 * db + 8 * q4 + 4 * hi;
            const u32x2 zz = *(const u32x2*)(zrow + d);
            u32x2 w;
            w.x = cvtpk(o[db][4 * q4 + 0] * bf2f(zz.x & 0xffffu), o[db][4 * q4 + 1] * bf2f(zz.x >> 16));
            w.y = cvtpk(o[db][4 * q4 + 2] * bf2f(zz.y & 0xffffu), o[db][4 * q4 + 3] * bf2f(zz.y >> 16));
            *(u32x2*)(orow + d) = w;
            if (q4 == 3) asm volatile("" ::: "memory");
        }
}

__device__ __forceinline__ float qk_bound(const float* gq, const float* gk, int lane) {
    float a = fabsf(gq[lane]), b = fabsf(gk[lane]);
#pragma unroll
    for (int o = 1; o < 64; o <<= 1) { a = fmaxf(a, __shfl_xor(a, o)); b = fmaxf(b, __shfl_xor(b, o)); }
    return 8.0f * a * b * LOG2E * 1.02f + 0.5f;
}
constexpr float ZCUT = 152.0f;
__device__ __forceinline__ int first_tile(int q0, float qkb, float sl2) {
    const float dc = (qkb + ZCUT) / sl2; const int dcut = dc > 1.0e9f ? (1 << 30) : (int)dc + 1;
    const int num = q0 - 63 - dcut; return num <= 0 ? 0 : (num + 63) / 64;
}

__device__ __forceinline__ int next_unit(unsigned* ctr, LAS unsigned char* lds, int& ticket) {
    volatile LAS int* slot = (volatile LAS int*)(lds + LDSCTL_OFF);
    __syncthreads();
    if (threadIdx.x == 0) *slot = ticket;
    __syncthreads();
    const int u = *slot;
    if (threadIdx.x == 0) ticket = (int)atomicAdd(ctr, 1u);
    return u;
}

__device__ __forceinline__ void unit_A(const Params& P, int u, LAS unsigned char* lds, float qkb, TP& tp) {
    int tid_ = threadIdx.x; asm volatile("" : "+v"(tid_));
    const int tid = tid_, lane = tid & 63, w = __builtin_amdgcn_readfirstlane(tid >> 6), r32 = lane & 31, hi = lane >> 5;
    const int half = u & 1, span = (u >> 1) & 15, h = (u >> 5) & 7, b = u >> 8;
    const int ph = 8 * half + w, t0 = 512 * span;
    const int tq = t0 + ph + 16 * r32;
    const bf16_t* Q = (const bf16_t*)(P.ws + WS_QKV) + (size_t)b * SEQ * PQ;
    const bf16_t* qrow = Q + (size_t)tq * PQ + h * 64;
    bf16x8 qr[4];
#pragma unroll
    for (int d0 = 0; d0 < 4; ++d0) qr[d0] = *(const bf16x8*)(qrow + d0 * 16 + hi * 8);
    const float sl2 = __builtin_amdgcn_exp2f(-(float)(h + 1)) * LOG2E;
    const float mref = fmaxf(qkb - 100.f, 0.f);
    f32x16 oT[2]; oT[0] = f32x16{}; oT[1] = f32x16{};
    float lsum = 0.f;
    LAS char* Kb = (LAS char*)lds + w * 16384; LAS char* Vb = Kb + 8192;
    const bf16_t* Kcol = Q + 512 + h * 64; const bf16_t* Vcol = Q + 1024 + h * 64;
#pragma unroll 1
    for (int pat = 0; pat < 3; ++pat) {
        const int pst = pat == 0 ? 1 : (pat == 1 ? 4 : 16), win = pat == 0 ? 128 : (pat == 1 ? 512 : 2048), ntile = pat == 0 ? 10 : (pat == 1 ? 4 : 3);
        const int pbase = pat == 0 ? (t0 - 128) : (t0 + ph - win);
        const float stepk = sl2 * (float)pst;
        const int dmaxe = win < tq ? win : tq;
#pragma unroll 1
        for (int k = 0; k < ntile; ++k) {
            const int p0 = pbase + 64 * pst * k, dq0 = tq - p0;
            const int dlo = dq0 - 63 * pst;
            const bool any_valid = __any((dq0 >= 0) && (dlo <= dmaxe) && (qkb - sl2 * (float)(dlo > 0 ? dlo : 0) - mref > -ZCUT));
            if (!any_valid) continue;
            LDS_WAIT();
#pragma unroll
            for (int i = 0; i < 8; ++i) { const int tok = clampi(p0 + pst * (8 * i + (lane >> 3)), 0, SEQ - 1); issue_piece(Kcol, PQ, tok, Kb, i, lane); issue_piece(Vcol, PQ, tok, Vb, i, lane); }
            VM_WAIT();
            attn_tile<2>(Kb, Vb, qr, oT, mref, lsum, -sl2 * (float)dq0, stepk, true, dq0, pst, 0, dmaxe, lane);
        }
    }
    const float inv = 1.0f / swap_add(lsum);
#pragma unroll
    for (int db = 0; db < 2; ++db)
#pragma unroll
        for (int r = 0; r < 16; ++r) oT[db][r] *= inv;
    bf16_t* mixed = (bf16_t*)(P.ws + WS_MIXED) + ((size_t)b * SEQ + tq) * DM + h * 64;
    store_rows<2>(oT, Q + (size_t)tq * PQ + 1536 + h * 64, mixed, hi);
}

__device__ __forceinline__ void unit_B(const Params& P, int b, int h, int qb, LAS unsigned char* lds, float qkb, TP& tp) {
    int tid_ = threadIdx.x; asm volatile("" : "+v"(tid_));
    const int tid = tid_, lane = tid & 63, w = __builtin_amdgcn_readfirstlane(tid >> 6), r32 = lane & 31, hi = lane >> 5;
    const int comp = w >> 2, qs = w & 3;
    const int tq = 128 * qb + 32 * qs + r32;
    const bf16_t* Q = (const bf16_t*)(P.ws + WS_QKV) + (size_t)b * SEQ * PQ;
    const bf16_t* qrow = Q + (size_t)tq * PQ + 2048 + h * 128 + comp * 64;
    bf16x8 qr[4];
#pragma unroll
    for (int d0 = 0; d0 < 4; ++d0) qr[d0] = *(const bf16x8*)(qrow + d0 * 16 + hi * 8);
    const float sl2 = __builtin_amdgcn_exp2f(-2.0f * (float)(h + 1)) * LOG2E;
    float lamv;
    { const float* lm = P.lam_e; const float a = lm[lane] * lm[64 + lane], c = lm[128 + lane] * lm[192 + lane];
      lamv = __expf(wave_sum(a)) - __expf(wave_sum(c)) + 0.2f; }
    f32x16 oT[4]; oT[0] = f32x16{}; oT[1] = f32x16{}; oT[2] = f32x16{}; oT[3] = f32x16{};
    const float mref = fmaxf(qkb - 100.f, 0.f);
    float lsum = 0.f;
    const bf16_t* Kcol = Q + 2560 + h * 128; const bf16_t* Vcol = Q + 3072 + h * 128;
    const int NTall = 2 * qb + 2;
    const int kt_min = first_tile(128 * qb, qkb - mref, sl2);
    const int NT = NTall - kt_min;
    auto issue = [&](int kt, int slot) {
#pragma unroll
        for (int t = 0; t < 2; ++t) {
            if (kt - t < kt_min) break;
            LAS char* Kb = (LAS char*)lds + slot * 65536 + t * 32768; LAS char* Vb = Kb + 16384;
            const int tk = 64 * (kt - t) + 8 * w + (lane >> 3);
#pragma unroll
            for (int j = 0; j < 2; ++j) { issue_piece(Kcol + j * 64, PQ, tk, Kb + j * 8192, w, lane); issue_piece(Vcol + j * 64, PQ, tk, Vb + j * 8192, w, lane); }
        }
    };
    const int NS = (NT + 1) >> 1;
    issue(NTall - 1, 0);
#pragma unroll 1
    for (int st = 0; st < NS; ++st) {
        const int kt = NTall - 1 - 2 * st;
        TP_BEGIN(31);
        VM_WAIT(); LDS_WAIT(); __builtin_amdgcn_s_barrier(); asm volatile("" ::: "memory");
        TP_END(31);
        if (st + 1 < NS) issue(kt - 2, (st + 1) & 1);
        TP_BEGIN(32);
        {   const LAS char* Kb = (const LAS char*)lds + (st & 1) * 65536 + comp * 8192; const LAS char* Vb = (const LAS char*)lds + (st & 1) * 65536 + 16384;
            const int dq0 = tq - 64 * kt;
            attn_tile<4>(Kb, Vb, qr, oT, mref, lsum, -sl2 * (float)dq0, sl2, kt >= 2 * qb, dq0, 1, 0, 1 << 30, lane); }
        if (kt - 1 >= kt_min) {
            const LAS char* Kb = (const LAS char*)lds + (st & 1) * 65536 + 32768 + comp * 8192; const LAS char* Vb = (const LAS char*)lds + (st & 1) * 65536 + 32768 + 16384;
            const int dq0 = tq - 64 * (kt - 1);
            attn_tile<4>(Kb, Vb, qr, oT, mref, lsum, -sl2 * (float)dq0, sl2, kt - 1 >= 2 * qb, dq0, 1, 0, 1 << 30, lane); }
        TP_END(32);
    }
    LDS_WAIT(); __syncthreads();
    const float inv = 1.0f / swap_add(lsum);
    LAS float* scr = (LAS float*)lds + qs * 4096;
    if (comp == 1) {
        const float f = inv * lamv;
#pragma unroll
        for (int db = 0; db < 4; ++db)
#pragma unroll
            for (int r = 0; r < 16; ++r) scr[(db * 16 + r) * 64 + lane] = oT[db][r] * f;
    }
    LDS_WAIT(); __syncthreads();
    if (comp == 0) {
        float ss = 0.f;
#pragma unroll
        for (int db = 0; db < 4; ++db) {
#pragma unroll
            for (int r = 0; r < 16; ++r) { const float v = oT[db][r] * inv - scr[(db * 16 + r) * 64 + lane]; oT[db][r] = v; ss += v * v; }
            asm volatile("" ::: "memory");
        }
        ss = swap_add(ss);
        const float rr = __builtin_amdgcn_rsqf(ss * (1.0f / 128.0f) + EPS) * 0.8f;
        const float* sg = P.subln_e;
#pragma unroll
        for (int db = 0; db < 4; ++db) {
#pragma unroll
            for (int q4 = 0; q4 < 4; ++q4) { const f32x4 gq = *(const f32x4*)(sg + 32 * db + 8 * q4 + 4 * hi);
#pragma unroll
                for (int e = 0; e < 4; ++e) oT[db][4 * q4 + e] *= rr * gq[e]; }
            asm volatile("" ::: "memory");
        }
        bf16_t* mixed = (bf16_t*)(P.ws + WS_MIXED) + ((size_t)b * SEQ + tq) * DM + 512 + h * 128;
        store_rows<4>(oT, Q + (size_t)tq * PQ + 3584 + h * 128, mixed, hi);
    }
    LDS_WAIT();
}

__device__ __forceinline__ bool better(float av, int an, float bv, int bn) { return av > bv || (av == bv && an < bn); }
__device__ __forceinline__ void unit_C(const Params& P, int b, int h, int i, LAS unsigned char* lds, float qkb, TP& tp) {
    int tid_ = threadIdx.x; asm volatile("" : "+v"(tid_));
    const int tid = tid_, lane = tid & 63, w = __builtin_amdgcn_readfirstlane(tid >> 6), r32 = lane & 31, hi = lane >> 5;
    const int tq = 256 * i + 32 * w + r32;
    const bf16_t* Q = (const bf16_t*)(P.ws + WS_QKV) + (size_t)b * SEQ * PQ;
    const bf16_t* qrow = Q + (size_t)tq * PQ + h * 64;
    bf16x8 qr[4];
#pragma unroll
    for (int d0 = 0; d0 < 4; ++d0) qr[d0] = *(const bf16x8*)(qrow + d0 * 16 + hi * 8);
    unsigned sel = 0u;
    if (i > 0) {
        const float* km = (const float*)(P.ws + WS_KMEAN) + (size_t)(b * 8 + h) * 32 * 64;
        LAS char* Th = (LAS char*)lds + 65536; LAS char* Tl = Th + 8192;
#pragma unroll
        for (int j = 0; j < 4; ++j) { const int idx = tid * 4 + j, n = idx >> 6, d = idx & 63; const float v = km[idx];
            const unsigned hb = f2bf(v); const unsigned lb = f2bf(v - bf2f(hb)); const int off = n * 128 + (((d >> 3) ^ tile_sw(n)) << 4) + (d & 7) * 2;
            *(LAS bf16_t*)(Th + off) = (bf16_t)hb; *(LAS bf16_t*)(Tl + off) = (bf16_t)lb; }
        LDS_WAIT(); __syncthreads();
        f32x16 g = f32x16{};
        const LAS char* kh = Th + r32 * 128; const LAS char* kl = Tl + r32 * 128; const int swk = tile_sw(r32);
#pragma unroll
        for (int d0 = 0; d0 < 4; ++d0) { const int off = ((2 * d0 + hi) ^ swk) << 4;
                                         g = __builtin_amdgcn_mfma_f32_32x32x16_bf16(*(const LAS bf16x8*)(kh + off), qr[d0], g, 0, 0, 0);
                                         g = __builtin_amdgcn_mfma_f32_32x32x16_bf16(*(const LAS bf16x8*)(kl + off), qr[d0], g, 0, 0, 0); }
        float v1 = -INFINITY, v2 = -INFINITY, v3 = -INFINITY; int n1 = 99, n2 = 99, n3 = 99;
#pragma unroll
        for (int r = 0; r < 16; ++r) { const int n = crow(r, hi); const float v = (n < i) ? g[r] : -INFINITY;
            if (v > v1) { v3 = v2; n3 = n2; v2 = v1; n2 = n1; v1 = v; n1 = n; }
            else if (v > v2) { v3 = v2; n3 = n2; v2 = v; n2 = n; }
            else if (v > v3) { v3 = v; n3 = n; } }
        float pv[3] = {__shfl_xor(v1, 32), __shfl_xor(v2, 32), __shfl_xor(v3, 32)}; int pn[3] = {__shfl_xor(n1, 32), __shfl_xor(n2, 32), __shfl_xor(n3, 32)};
#pragma unroll
        for (int k = 0; k < 3; ++k) { const float v = pv[k]; const int n = pn[k];
            if (better(v, n, v1, n1)) { v3 = v2; n3 = n2; v2 = v1; n2 = n1; v1 = v; n1 = n; }
            else if (better(v, n, v2, n2)) { v3 = v2; n3 = n2; v2 = v; n2 = n; }
            else if (better(v, n, v3, n3)) { v3 = v; n3 = n; } }
        if (v1 > -INFINITY) sel |= 1u << n1; if (v2 > -INFINITY) sel |= 1u << n2; if (v3 > -INFINITY) sel |= 1u << n3;
    }
    const float sl2 = __builtin_amdgcn_exp2f(-(float)(h + 1)) * LOG2E;
    f32x16 oT[2]; oT[0] = f32x16{}; oT[1] = f32x16{};
    const float mref = fmaxf(qkb - 100.f, 0.f);
    float lsum = 0.f;
    const bf16_t* Kcol = Q + 512 + h * 64; const bf16_t* Vcol = Q + 1024 + h * 64;
    const int NTall = 4 * i + 4;
    const int NT = NTall - first_tile(256 * i, qkb - mref, sl2);
    const int kt_min = NTall - NT;
    auto issue = [&](int kt, int slot) {
#pragma unroll
        for (int t = 0; t < 2; ++t) {
            if (kt - t < kt_min) break;
            LAS char* Kb = (LAS char*)lds + slot * 32768 + t * 16384; LAS char* Vb = Kb + 8192;
            issue_piece(Kcol, PQ, 64 * (kt - t) + 8 * w + (lane >> 3), Kb, w, lane);
            issue_piece(Vcol, PQ, 64 * (kt - t) + 8 * w + (lane >> 3), Vb, w, lane);
        }
    };
    const int NS = (NT + 1) >> 1;
    issue(NTall - 1, 0);
#pragma unroll 1
    for (int st = 0; st < NS; ++st) {
        const int kt = NTall - 1 - 2 * st;
        TP_BEGIN(31);
        VM_WAIT(); LDS_WAIT(); __builtin_amdgcn_s_barrier(); asm volatile("" ::: "memory");
        TP_END(31);
        if (st + 1 < NS) issue(kt - 2, (st + 1) & 1);
        TP_BEGIN(32);
#pragma unroll
        for (int t = 0; t < 2; ++t) {
            const int k2 = kt - t;
            if (k2 < kt_min) break;
            const LAS char* Kb = (const LAS char*)lds + (st & 1) * 32768 + t * 16384; const LAS char* Vb = Kb + 8192;
            const int dq0 = tq - 64 * k2; const bool own = k2 >= 4 * i;
            const bool on = own || ((sel >> (k2 >> 2)) & 1u);
            if (__any(on)) attn_tile<2>(Kb, Vb, qr, oT, mref, lsum, on ? -sl2 * (float)dq0 : -INFINITY, sl2, own, dq0, 1, 0, 1 << 30, lane);
        }
        TP_END(32);
    }
    const float inv = 1.0f / swap_add(lsum);
#pragma unroll
    for (int db = 0; db < 2; ++db)
#pragma unroll
        for (int r = 0; r < 16; ++r) oT[db][r] *= inv;
    bf16_t* mixed = (bf16_t*)(P.ws + WS_MIXED) + ((size_t)b * SEQ + tq) * DM + h * 64;
    store_rows<2>(oT, Q + (size_t)tq * PQ + 1536 + h * 64, mixed, hi);
    LDS_WAIT();
}

constexpr int IMP_PITCH = 132;
__device__ __forceinline__ unsigned dpp_max_u32_8(unsigned v) {
    unsigned t;
    t = (unsigned)__builtin_amdgcn_update_dpp(0, (int)v, 0xB1, 0xF, 0xF, true); v = v > t ? v : t;
    t = (unsigned)__builtin_amdgcn_update_dpp(0, (int)v, 0x4E, 0xF, 0xF, true); v = v > t ? v : t;
    t = (unsigned)__builtin_amdgcn_update_dpp(0, (int)v, 0x141, 0xF, 0xF, true); v = v > t ? v : t;
    return v;
}
__device__ __forceinline__ void unit_D(const Params& P, int b, int hkv, int qt, LAS unsigned char* lds, float qkb_cmp, float qkbs, float qkb_win, TP& tp) {
    int tid_ = threadIdx.x; asm volatile("" : "+v"(tid_));
    const int tid = tid_, lane = tid & 63, w = __builtin_amdgcn_readfirstlane(tid >> 6), r32 = lane & 31, hi = lane >> 5;
    const int qi = r32 & 7, g = r32 >> 3, hq = 4 * hkv + g;
    const int ql = 8 * w + qi, tq = 64 * qt + ql;
    const bf16_t* Q = (const bf16_t*)(P.ws + WS_QKV) + (size_t)b * SEQ * PQ;
    const bf16_t* qrow = Q + (size_t)tq * PQ + 2048 + hq * 64;
    bf16x8 qr[4];
#pragma unroll
    for (int d0 = 0; d0 < 4; ++d0) qr[d0] = *(const bf16x8*)(qrow + d0 * 16 + hi * 8);
    const float sl2 = __builtin_amdgcn_exp2f(-(float)(hq + 1)) * LOG2E;
    LAS float* imp = (LAS float*)(lds + 32768);
    LAS unsigned short* selm = (LAS unsigned short*)(lds + 67584);
    LAS unsigned* uni = (LAS unsigned*)(lds + 68608);
    for (int k = tid; k < 64 * IMP_PITCH; k += NTHREADS) imp[k] = 0.f;
    if (tid < 4) uni[tid] = 0u;
    LAS float* stash = (LAS float*)(lds + 69632) + w * 2048 + lane;
    const bf16_t* gp = Q + (size_t)tq * PQ + 3840 + 3 * hq;

#ifndef D_NOCMP
    {
        const bf16_t* Kc = (const bf16_t*)(P.ws + WS_KCMP) + (size_t)(b * 2 + hkv) * 512 * 64;
        const bf16_t* Vc = (const bf16_t*)(P.ws + WS_VCMP) + (size_t)(b * 2 + hkv) * 512 * 64;
        const int NTc = (4 * qt + 2) / 64 + 1;
        const float stepk = sl2 * 16.f;
        auto issue = [&](int ti, int s, bool withv) {
            LAS char* Kb = (LAS char*)lds + s * 16384; LAS char* Vb = Kb + 8192;
            issue_piece(Kc, 64, 64 * ti + 8 * w + (lane >> 3), Kb, w, lane);
            if (withv) issue_piece(Vc, 64, 64 * ti + 8 * w + (lane >> 3), Vb, w, lane);
        };
        TP_BEGIN(40);
        const float mref = fmaxf(qkb_cmp - 100.f, 0.f);
        float lsum = 0.f;
        issue(0, 0, false);
#pragma unroll 1
        for (int ti = 0; ti < NTc; ++ti) {
            VM_WAIT(); __syncthreads();
            if (ti + 1 < NTc) issue(ti + 1, (ti + 1) & 1, false);
            const LAS char* Kb = (const LAS char*)lds + (ti & 1) * 16384;
            const int dq0 = tq - (1024 * ti + 31);
            f32x16 p0, p1;
            qk_tile(p0, p1, Kb, qr, -sl2 * (float)dq0 - mref, stepk, r32, hi);
            mask_tile(p0, p1, dq0, 16, 0, 1 << 30, hi);
            float s = 0.f;
#pragma unroll
            for (int r = 0; r < 16; ++r) s += __builtin_amdgcn_exp2f(p0[r]) + __builtin_amdgcn_exp2f(p1[r]);
            lsum += s;
        }
        const float ltot = swap_add(lsum);
        const float linv = ltot > 0.f ? 1.0f / ltot : 0.f;
        __syncthreads();
        TP_END(40); TP_BEGIN(41);
        f32x16 oT[2]; oT[0] = f32x16{}; oT[1] = f32x16{};
        bf16x8 mfr[4];
#pragma unroll
        for (int ks = 0; ks < 4; ++ks) { u32x4 t;
#pragma unroll
            for (int pr = 0; pr < 4; ++pr) { unsigned wv = 0u;
#pragma unroll
                for (int o = 0; o < 2; ++o) { const int ii = 2 * pr + o, nl = 16 * ks + 8 * (ii >> 2) + 4 * hi + (ii & 3); if (nl >= 4 * r32 - 1 && nl <= 4 * r32 + 3) wv |= 0x3F80u << (16 * o); }
                t[pr] = wv; }
            mfr[ks] = __builtin_bit_cast(bf16x8, t); }
        issue(0, 0, true);
#pragma unroll 1
        for (int ti = 0; ti < NTc; ++ti) {
            VM_WAIT(); __syncthreads();
            if (ti + 1 < NTc) issue(ti + 1, (ti + 1) & 1, true);
            const LAS char* Kb = (const LAS char*)lds + (ti & 1) * 16384; const LAS char* Vb = Kb + 8192;
            const int dq0 = tq - (1024 * ti + 31);
            f32x16 p0, p1;
            qk_tile(p0, p1, Kb, qr, -sl2 * (float)dq0 - mref, stepk, r32, hi);
            mask_tile(p0, p1, dq0, 16, 0, 1 << 30, hi);
#pragma unroll
            for (int r = 0; r < 16; ++r) { p0[r] = __builtin_amdgcn_exp2f(p0[r]) * linv; p1[r] = __builtin_amdgcn_exp2f(p1[r]) * linv; }
            bf16x8 pw[4]; pack_p(pw, p0, p1);
            f32x16 ic = f32x16{};
#pragma unroll
            for (int ks = 0; ks < 4; ++ks) ic = __builtin_amdgcn_mfma_f32_32x32x16_bf16(pw[ks], mfr[ks], ic, 0, 0, 0);
            if (r32 <= 16) {
#pragma unroll
                for (int e = 0; e < 4; ++e) { LAS float* ip = imp + (8 * w + e + 4 * hi) * IMP_PITCH + 16 * ti + r32; ip[0] += (ic[e] + ic[4 + e]) + (ic[8 + e] + ic[12 + e]); }
            }
            pv_tile<2>(oT, Vb, pw, lane);
        }
        const float g0 = bf2f(gp[0]);
#pragma unroll
        for (int db = 0; db < 2; ++db)
#pragma unroll
            for (int r = 0; r < 16; ++r) stash[(db * 16 + r) * 64] = g0 * oT[db][r];
    }
#endif
    LDS_WAIT(); __syncthreads();
    TP_END(41); TP_BEGIN(42);
#ifndef D_NOTOPK
    {
        const int qq = 8 * w + (lane >> 3), sub = lane & 7;
        unsigned key[16];
#pragma unroll
        for (int k = 0; k < 16; ++k) { const int j = 16 * sub + k; const float v = imp[qq * IMP_PITCH + j];
            unsigned kk = ((__float_as_uint(v) >> 7) << 7) + (unsigned)(128 - j);
            if (j == 0 || j == qt || j == qt - 1) kk = 0xFFFFFF00u | (unsigned)(128 - j);
            if (j > qt) kk = 0u;
            key[k] = kk; }
        unsigned selb = 0u;
#pragma unroll 1
        for (int round = 0; round < 16; ++round) {
            unsigned lm = key[0];
#pragma unroll
            for (int k = 1; k < 16; ++k) lm = key[k] > lm ? key[k] : lm;
            const unsigned gm = dpp_max_u32_8(lm);
            if (gm != 0u) {
#pragma unroll
                for (int k = 0; k < 16; ++k) { const bool hit = key[k] == gm; selb |= hit ? (1u << k) : 0u; key[k] = hit ? 0u : key[k]; }
            }
        }
        selm[qq * 8 + sub] = (unsigned short)selb;
    }
#endif
    LDS_WAIT(); __syncthreads();
    unsigned msk[4];
    { const LAS unsigned* mp = (const LAS unsigned*)(selm + ql * 8); msk[0] = mp[0]; msk[1] = mp[1]; msk[2] = mp[2]; msk[3] = mp[3]; }
    {
        unsigned o0 = msk[0], o1 = msk[1], o2 = msk[2], o3 = msk[3];
#pragma unroll
        for (int s = 1; s < 8; s <<= 1) { o0 |= __shfl_xor(o0, s); o1 |= __shfl_xor(o1, s); o2 |= __shfl_xor(o2, s); o3 |= __shfl_xor(o3, s); }
        if (lane == 0) { atomicOr((unsigned*)&uni[0], o0); atomicOr((unsigned*)&uni[1], o1); atomicOr((unsigned*)&uni[2], o2); atomicOr((unsigned*)&uni[3], o3); }
    }
    LDS_WAIT(); __syncthreads();
    unsigned um[4] = {uni[0], uni[1], uni[2], uni[3]};
    um[0] = __builtin_amdgcn_readfirstlane(um[0]); um[1] = __builtin_amdgcn_readfirstlane(um[1]); um[2] = __builtin_amdgcn_readfirstlane(um[2]); um[3] = __builtin_amdgcn_readfirstlane(um[3]);
    TP_END(42); TP_BEGIN(43);
#ifndef D_NOSLC
    {
        const bf16_t* Kcol = Q + 2816 + hkv * 64; const bf16_t* Vcol = Q + 2944 + hkv * 64;
        auto nextblk = [&](int below) -> int {
            for (int wd = 3; wd >= 0; --wd) { unsigned m = um[wd]; const int lim = below - 32 * wd; if (lim <= 0) continue; if (lim < 32) m &= (1u << lim) - 1u; if (m) return 32 * wd + 31 - __builtin_clz(m); }
            return -1;
        };
        auto issue = [&](int j, int s) {
            LAS char* Kb = (LAS char*)lds + s * 16384; LAS char* Vb = Kb + 8192;
            issue_piece(Kcol, PQ, 64 * j + 8 * w + (lane >> 3), Kb, w, lane);
            issue_piece(Vcol, PQ, 64 * j + 8 * w + (lane >> 3), Vb, w, lane);
        };
        f32x16 oT[2]; oT[0] = f32x16{}; oT[1] = f32x16{};
        const float mref = fmaxf(qkbs - 100.f, 0.f);
        float lsum = 0.f;
        const int jmin = first_tile(64 * qt, qkbs - mref, __builtin_amdgcn_exp2f(-(float)(4 * hkv + 4)) * LOG2E);
        int j = nextblk(128), it = 0;
        if (j < jmin) j = -1;
        if (j >= 0) issue(j, 0);
#pragma unroll 1
        while (j >= 0) {
            int jn = nextblk(j); if (jn < jmin) jn = -1;
            VM_WAIT(); __syncthreads();
            if (jn >= 0) issue(jn, (it + 1) & 1);
            const LAS char* Kb = (const LAS char*)lds + (it & 1) * 16384; const LAS char* Vb = Kb + 8192;
            const int dq0 = tq - 64 * j;
            const unsigned mw = j < 32 ? msk[0] : (j < 64 ? msk[1] : (j < 96 ? msk[2] : msk[3]));
            const bool on = (mw >> (j & 31)) & 1u;
            if (__any(on))
                attn_tile<2>(Kb, Vb, qr, oT, mref, lsum, on ? -sl2 * (float)dq0 : -INFINITY, sl2, j == qt, dq0, 1, 0, 1 << 30, lane);
            j = jn; ++it;
        }
        const float f = bf2f(gp[1]) / swap_add(lsum);
#pragma unroll
        for (int db = 0; db < 2; ++db)
#pragma unroll
            for (int r = 0; r < 16; ++r) stash[(db * 16 + r) * 64] += f * oT[db][r];
    }
#endif
    __syncthreads();
    TP_END(43); TP_BEGIN(44);
#ifndef D_NOWIN
    {
        const bf16_t* Kcol = Q + 3072 + hkv * 64; const bf16_t* Vcol = Q + 3200 + hkv * 64;
        auto issue = [&](int kt, int s) {
            LAS char* Kb = (LAS char*)lds + s * 16384; LAS char* Vb = Kb + 8192;
            issue_piece(Kcol, PQ, 64 * kt + 8 * w + (lane >> 3), Kb, w, lane);
            issue_piece(Vcol, PQ, 64 * kt + 8 * w + (lane >> 3), Vb, w, lane);
        };
        f32x16 oT[2]; oT[0] = f32x16{}; oT[1] = f32x16{};
        const float mref = fmaxf(qkb_win - 100.f, 0.f);
        float lsum = 0.f;
        const int klo = qt - 8 > 0 ? qt - 8 : 0, NT = qt - klo + 1;
        issue(qt, 0);
#pragma unroll 1
        for (int it = 0; it < NT; ++it) {
            const int kt = qt - it;
            VM_WAIT(); __syncthreads();
            if (it + 1 < NT) issue(kt - 1, (it + 1) & 1);
            const LAS char* Kb = (const LAS char*)lds + (it & 1) * 16384; const LAS char* Vb = Kb + 8192;
            const int dq0 = tq - 64 * kt;
            attn_tile<2>(Kb, Vb, qr, oT, mref, lsum, -sl2 * (float)dq0, sl2, (kt == qt) || (kt == qt - 8), dq0, 1, 0, 511, lane);
        }
        const float f = bf2f(gp[2]) / swap_add(lsum);
#pragma unroll
        for (int db = 0; db < 2; ++db)
#pragma unroll
            for (int r = 0; r < 16; ++r) oT[db][r] = stash[(db * 16 + r) * 64] + f * oT[db][r];
        bf16_t* mixed = (bf16_t*)(P.ws + WS_MIXED) + ((size_t)b * SEQ + tq) * DM + 512 + hq * 64;
        store_rows<2>(oT, Q + (size_t)tq * PQ + 3328 + hq * 64, mixed, hi);
    }
#endif
    TP_END(44);
    LDS_WAIT();
}

__device__ __forceinline__ void kmean_unit(const Params& P, int u, int lane) {
    const int blk = u & 31, h = (u >> 5) & 7, b = u >> 8;
    const bf16_t* K = (const bf16_t*)(P.ws + WS_QKV) + ((size_t)b * SEQ + 256 * blk) * PQ + 512 + h * 64;
    float a[8] = {0.f, 0.f, 0.f, 0.f, 0.f, 0.f, 0.f, 0.f};
    const int c = lane & 7, rs = lane >> 3;
#pragma unroll 4
    for (int it = 0; it < 32; ++it) { const u32x4 v = *(const u32x4*)(K + (size_t)(8 * it + rs) * PQ + 8 * c);
        a[0] += bf2f(v.x & 0xffffu); a[1] += bf2f(v.x >> 16); a[2] += bf2f(v.y & 0xffffu); a[3] += bf2f(v.y >> 16);
        a[4] += bf2f(v.z & 0xffffu); a[5] += bf2f(v.z >> 16); a[6] += bf2f(v.w & 0xffffu); a[7] += bf2f(v.w >> 16); }
#pragma unroll
    for (int k = 0; k < 8; ++k) { float s = a[k]; s += __shfl_xor(s, 8); s += __shfl_xor(s, 16); s += __shfl_xor(s, 32); a[k] = s * (1.0f / 256.0f); }
    if (rs == 0) { float* o = (float*)(P.ws + WS_KMEAN) + (size_t)u * 64 + 8 * c;
        *(f32x4*)o = (f32x4){a[0], a[1], a[2], a[3]}; *(f32x4*)(o + 4) = (f32x4){a[4], a[5], a[6], a[7]}; }
}
__device__ __forceinline__ void compress_unit(const Params& P, int u, int lane) {
    const int chunk = u & 15, hkv = (u >> 4) & 1, b = (u >> 5) & 3, which = u >> 7;
    const int r32 = lane & 31, hi = lane >> 5;
    const int n = 32 * chunk + r32, nc = n > 510 ? 510 : n;
    const bf16_t* X = (const bf16_t*)(P.ws + WS_QKV) + ((size_t)b * SEQ + 16 * nc) * PQ + (which ? 2688 : 2560) + hkv * 64 + 8 * hi;
    const bf16_t* W1 = (const bf16_t*)(P.ws + WS_W1T) + (size_t)which * 128 * 2048 + (size_t)r32 * 2048 + 8 * hi;
    f32x16 hT[4]; hT[0] = f32x16{}; hT[1] = f32x16{}; hT[2] = f32x16{}; hT[3] = f32x16{};
#pragma unroll 4
    for (int ks = 0; ks < 128; ++ks) {
        const bf16x8 xb = *(const bf16x8*)(X + (size_t)(ks >> 2) * PQ + (ks & 3) * 16);
#pragma unroll
        for (int cb = 0; cb < 4; ++cb) { const bf16x8 wa = *(const bf16x8*)(W1 + (size_t)cb * 32 * 2048 + ks * 16);
            hT[cb] = __builtin_amdgcn_mfma_f32_32x32x16_bf16(wa, xb, hT[cb], 0, 0, 0); }
    }
    const float* b1 = (const float*)(P.ws + WS_BIAS1) + which * 128;
    const bf16_t* W2 = (const bf16_t*)(P.ws + WS_W2T) + (size_t)which * 64 * 128;
    f32x16 oT[2]; oT[0] = f32x16{}; oT[1] = f32x16{};
#pragma unroll
    for (int cb = 0; cb < 4; ++cb) {
#pragma unroll
        for (int r = 0; r < 16; ++r) { const float t = hT[cb][r] + b1[32 * cb + crow(r, hi)]; hT[cb][r] = t / (1.0f + __builtin_amdgcn_exp2f(-t * LOG2E)); }
#pragma unroll
        for (int s = 0; s < 2; ++s) {
            u32x4 pb; pb.x = cvtpk(hT[cb][8 * s + 0], hT[cb][8 * s + 1]); pb.y = cvtpk(hT[cb][8 * s + 2], hT[cb][8 * s + 3]); pb.z = cvtpk(hT[cb][8 * s + 4], hT[cb][8 * s + 5]); pb.w = cvtpk(hT[cb][8 * s + 6], hT[cb][8 * s + 7]);
            const bf16x8 bfrag = __builtin_bit_cast(bf16x8, pb);
#pragma unroll
            for (int ob = 0; ob < 2; ++ob) { const bf16_t* wp = W2 + (size_t)(32 * ob + r32) * 128 + 32 * cb + 16 * s + 4 * hi;
                const u32x2 a0 = *(const u32x2*)wp, a1 = *(const u32x2*)(wp + 8);
                const bf16x8 afrag = __builtin_bit_cast(bf16x8, (u32x4){a0.x, a0.y, a1.x, a1.y});
                oT[ob] = __builtin_amdgcn_mfma_f32_32x32x16_bf16(afrag, bfrag, oT[ob], 0, 0, 0); }
        }
    }
    if (which == 0) {
        float ss = 0.f;
#pragma unroll
        for (int ob = 0; ob < 2; ++ob)
#pragma unroll
            for (int r = 0; r < 16; ++r) ss += oT[ob][r] * oT[ob][r];
        ss = swap_add(ss);
        const float rr = __builtin_amdgcn_rsqf(ss * (1.0f / 64.0f) + EPS); const float* gn = P.qkn_o + 192;
#pragma unroll
        for (int ob = 0; ob < 2; ++ob)
#pragma unroll
            for (int r = 0; r < 16; ++r) oT[ob][r] *= rr * gn[32 * ob + crow(r, hi)];
    }
    bf16_t* orow = (bf16_t*)(P.ws + (which ? WS_VCMP : WS_KCMP)) + ((size_t)(b * 2 + hkv) * 512 + n) * 64;
#pragma unroll
    for (int ob = 0; ob < 2; ++ob)
#pragma unroll
        for (int q4 = 0; q4 < 4; ++q4) { u32x2 wv; wv.x = cvtpk(oT[ob][4 * q4], oT[ob][4 * q4 + 1]); wv.y = cvtpk(oT[ob][4 * q4 + 2], oT[ob][4 * q4 + 3]);
            *(u32x2*)(orow + 32 * ob + 8 * q4 + 4 * hi) = wv; }
}

__global__ void __launch_bounds__(NTHREADS, 2) mk_fwd(Params P) {
    extern __shared__ __attribute__((aligned(16))) unsigned char lds_raw[];
    LAS unsigned char* lds = (LAS unsigned char*)lds_raw;
    const int tid = threadIdx.x, lane = tid & 63, wave = __builtin_amdgcn_readfirstlane(tid >> 6);
    const int G = gridDim.x;
    const int gw = blockIdx.x * NWAVES + wave, NGW = G * NWAVES;
    unsigned* ctl = (unsigned*)(P.ws + WS_CTL);
    bf16_t* Wt_in_e = (bf16_t*)(P.ws + WS_WIN_E); bf16_t* Wt_out_e = (bf16_t*)(P.ws + WS_WOUT_E);
    bf16_t* Wt_in_o = (bf16_t*)(P.ws + WS_WIN_O); bf16_t* Wt_out_o = (bf16_t*)(P.ws + WS_WOUT_O);
    bf16_t* XN = (bf16_t*)(P.ws + WS_XN); bf16_t* MIXED = (bf16_t*)(P.ws + WS_MIXED); bf16_t* QKV = (bf16_t*)(P.ws + WS_QKV);
    float* SSQ0 = (float*)(P.ws + WS_SSQ0); float* SSQ1 = (float*)(P.ws + WS_SSQ1);
    TP tp; tp.t0 = 0; tp.acc = 0;
#if MK_LAUNCHES == 1
    cg::grid_group grid = cg::this_grid();
    volatile LAS unsigned* bst = (volatile LAS unsigned*)(lds + LDSCTL_OFF + 16);
    if (tid < 2) bst[tid] = 0u;
    __syncthreads();
    XcdBarrier xbar = xcd_barrier_post(ctl + 1024, bst);
#define SEAM(k) do { if (P.ph_lo <= (k) && (k) + 1 < P.ph_hi) { if ((k) == 0) grid.sync(); else xcd_barrier(xbar); } } while (0)
#else
#define SEAM(k) do { } while (0)
#endif
#define IN(k) (P.ph_lo <= (k) && (k) < P.ph_hi)

    TP_BEGIN(10);
    if (IN(0)) {
        LAS float* scr = (LAS float*)(lds + wave * 16384);
        constexpr int I_IN = 16 * 128, I_OUT = 16 * 32, I_W1 = 32 * 4, I_W2 = 2 * 2;
        constexpr int NIT = 2 * I_IN + 2 * I_OUT + 2 * I_W1 + 2 * I_W2;
        for (int it = gw; it < NIT; it += NGW) {
            int r = it;
            if (r < I_IN) { transpose_item(P.w_in_e, DM, 4096, Wt_in_e, true, P.ln_e, scr, r, lane, 128); continue; } r -= I_IN;
            if (r < I_IN) { transpose_item(P.w_in_o, DM, ODD_N, Wt_in_o, true, P.ln_o, scr, r, lane, 128); continue; } r -= I_IN;
            if (r < I_OUT) { transpose_item(P.w_out_e, DM, DM, Wt_out_e, false, nullptr, scr, r, lane, 32); continue; } r -= I_OUT;
            if (r < I_OUT) { transpose_item(P.w_out_o, DM, DM, Wt_out_o, false, nullptr, scr, r, lane, 32); continue; } r -= I_OUT;
            if (r < 2 * I_W1) { const int wh = r / I_W1; transpose_item(P.phi_w1 + (size_t)wh * 2048 * 128, 2048, 128, (bf16_t*)(P.ws + WS_W1T) + (size_t)wh * 128 * 2048, false, nullptr, scr, r % I_W1, lane, 4); continue; } r -= 2 * I_W1;
            { const int wh = r / I_W2; transpose_item(P.phi_w2 + (size_t)wh * 128 * 64, 128, 64, (bf16_t*)(P.ws + WS_W2T) + (size_t)wh * 64 * 128, false, nullptr, scr, r % I_W2, lane, 2); }
        }
        for (int it = gw; it < 256; it += NGW) { const int wh = it >> 7, c = it & 127; const float* pe = P.phi_pe + (size_t)wh * 2048; const float* w1 = P.phi_w1 + (size_t)wh * 2048 * 128;
            float s = 0.f; for (int k = lane; k < 2048; k += 64) s += pe[k] * w1[(size_t)k * 128 + c]; s = wave_sum(s);
            if (lane == 0) ((float*)(P.ws + WS_BIAS1))[it] = s; }
        for (int m = gw; m < MTOK; m += NGW) {
            const f32x4* xr = (const f32x4*)(P.x + (size_t)m * DM) + lane; f32x4 v[4]; float s = 0.f;
#pragma unroll
            for (int j = 0; j < 4; ++j) { v[j] = xr[64 * j]; s += (v[j][0] * v[j][0] + v[j][1] * v[j][1]) + (v[j][2] * v[j][2] + v[j][3] * v[j][3]); }
            s = wave_sum(s);
            u32x2* o8 = (u32x2*)(XN + (size_t)m * DM) + lane;
#pragma unroll
            for (int j = 0; j < 4; ++j) { u32x2 wv; wv.x = cvtpk(v[j][0], v[j][1]); wv.y = cvtpk(v[j][2], v[j][3]); o8[64 * j] = wv; }
            if (lane == 0) { SSQ0[m] = s; SSQ1[m] = 0.f; }
        }
    }
    TP_END(10);
    TP_BEGIN(20);
    SEAM(0);
    TP_END(20);
    TP_BEGIN(11);
    if (IN(1)) {
        pg8::Gemm g{XN, Wt_in_e, MTOK, 4096, DM}; pg8::StaticOrder S; S.init(MTOK, 4096, G, (int)blockIdx.x, REP_G1);
        EpiIn E{QKV, SSQ0, P.qkn_e, 0};
        pg8::gemm_phase<EpiIn>(lds, g, S, E);
    }
    TP_END(11);
    TP_BEGIN(21);
    SEAM(1);
    TP_END(21);
    TP_BEGIN(12);
    if (IN(2)) {
        const float qkbA = qk_bound(P.qkn_e, P.qkn_e + 64, lane), qkbB = qk_bound(P.qkn_e + 128, P.qkn_e + 192, lane);
        int ticket = 0; if (tid == 0) ticket = (int)atomicAdd(ctl + 64, 1u);
        for (;;) {
            TP_BEGIN(30); const int u = next_unit(ctl + 64, lds, ticket); TP_END(30);
            if (u >= 2048) break;
            if (u < 512) { if (EN_B) { _Pragma("unroll 1") for (int rep = 0; rep < REP_B; ++rep) unit_B(P, (u >> 1) & 3, 2 + (u & 1), 63 - (u >> 3), lds, qkbB, tp); } }
            else if (u < 768) { const int v = u - 512; if (EN_B) { _Pragma("unroll 1") for (int rep = 0; rep < REP_B; ++rep) unit_B(P, v & 3, 1, 63 - (v >> 2), lds, qkbB, tp); } }
            else if (u < 1792) { if (EN_A) { _Pragma("unroll 1") for (int rep = 0; rep < REP_A; ++rep) unit_A(P, u - 768, lds, qkbA, tp); } }
            else { const int v = u - 1792; if (EN_B) { _Pragma("unroll 1") for (int rep = 0; rep < REP_B; ++rep) unit_B(P, v & 3, 0, 63 - (v >> 2), lds, qkbB, tp); } }
        }
    }
    TP_END(12);
    TP_BEGIN(22);
    SEAM(2);
    TP_END(22);
    TP_BEGIN(13);
    if (IN(3)) {
        pg8::Gemm g{MIXED, Wt_out_e, MTOK, DM, DM}; pg8::StaticOrder S; S.init(MTOK, DM, G, (int)blockIdx.x, REP_G2);
        EpiOut E{P.x, P.out, XN, SSQ1};
        pg8::gemm_phase<EpiOut>(lds, g, S, E);
    }
    TP_END(13);
    TP_BEGIN(23);
    SEAM(3);
    TP_END(23);
    TP_BEGIN(14);
    if (IN(4)) {
        pg8::Gemm g{XN, Wt_in_o, MTOK, 4096, DM}; pg8::StaticOrder S; S.init(MTOK, 4096, G, (int)blockIdx.x);
        EpiIn E{QKV, SSQ1, P.qkn_o, 1};
        pg8::gemm_phase<EpiIn>(lds, g, S, E);
    }
    TP_END(14);
    TP_BEGIN(24);
    SEAM(4);
    TP_END(24);
    TP_BEGIN(15);
    if (IN(5)) {
        if (wave == 0) { for (int it = blockIdx.x; it < 256; it += G) compress_unit(P, it, lane); }
        else { for (int it = blockIdx.x * (NWAVES - 1) + wave - 1; it < 1024; it += G * (NWAVES - 1)) kmean_unit(P, it, lane); }
    }
    TP_END(15);
    TP_BEGIN(25);
    SEAM(5);
    TP_END(25);
    TP_BEGIN(16);
    if (IN(6)) {
        const float qkbC = qk_bound(P.qkn_o, P.qkn_o + 64, lane), qkbD0 = qk_bound(P.qkn_o + 128, P.qkn_o + 192, lane),
                    qkbD1 = qk_bound(P.qkn_o + 128, P.qkn_o + 256, lane), qkbD2 = qk_bound(P.qkn_o + 128, P.qkn_o + 320, lane);
        int ticket = 0; if (tid == 0) ticket = (int)atomicAdd(ctl + 128, 1u);
        for (;;) {
            TP_BEGIN(30); const int u = next_unit(ctl + 128, lds, ticket); TP_END(30);
            if (u >= 2048) break;
            if (u < 512) { if (EN_C) { _Pragma("unroll 1") for (int rep = 0; rep < REP_C; ++rep) unit_C(P, (u >> 2) & 3, 4 + (u & 3), 31 - (u >> 4), lds, qkbC, tp); } }
            else if (u < 1536) { const int v = u - 512; if (EN_D) { _Pragma("unroll 1") for (int rep = 0; rep < REP_D; ++rep) unit_D(P, (v & 7) >> 1, v & 1, 127 - (v >> 3), lds, qkbD0, qkbD1, qkbD2, tp); } }
            else { const int v = u - 1536; if (EN_C) { _Pragma("unroll 1") for (int rep = 0; rep < REP_C; ++rep) unit_C(P, (v >> 2) & 3, v & 3, 31 - (v >> 4), lds, qkbC, tp); } }
        }
    }
    TP_END(16);
    TP_BEGIN(26);
    SEAM(6);
    TP_END(26);
    TP_BEGIN(17);
    if (IN(7)) {
        pg8::Gemm g{MIXED, Wt_out_o, MTOK, DM, DM}; pg8::StaticOrder S; S.init(MTOK, DM, G, (int)blockIdx.x);
        EpiOut E{P.out, P.out, nullptr, nullptr};
        pg8::gemm_phase<EpiOut>(lds, g, S, E);
    }
    TP_END(17);
    if (PROBE_ID != 1 && blockIdx.x == 0 && wave == 0) { const unsigned long long t0 = tp_now(); while (tp_now() - t0 < tp.acc) __builtin_amdgcn_s_sleep(8); }
#undef IN
#undef SEAM
}

extern "C" void kernel_launch(void* const* d_in, const int* in_sizes, int n_in, void* d_out, int out_size, void* d_ws, size_t ws_size, hipStream_t stream) {
    static int grid = 0;
    if (grid == 0) {
        if (n_in != 14 || in_sizes[0] != MTOK * DM || out_size != MTOK * DM || ws_size < WS_END) { fprintf(stderr, "kernel_launch: unexpected shapes (n_in %d, in0 %d, out %d, ws %zu)\n", n_in, n_in > 0 ? in_sizes[0] : -1, out_size, ws_size); grid = -1; return; }
        int dev = 0, cus = 0, per_cu = 0;
        hipGetDevice(&dev); hipDeviceGetAttribute(&cus, hipDeviceAttributeMultiprocessorCount, dev);
        if (hipFuncSetAttribute((const void*)mk_fwd, hipFuncAttributeMaxDynamicSharedMemorySize, LDS_BYTES) != hipSuccess) { fprintf(stderr, "kernel_launch: hipFuncSetAttribute failed\n"); grid = -1; return; }
        hipOccupancyMaxActiveBlocksPerMultiprocessor(&per_cu, (const void*)mk_fwd, NTHREADS, LDS_BYTES);
        (void)hipGetLastError();
        if (per_cu < 1) { fprintf(stderr, "kernel_launch: occupancy query says %d blocks per CU\n", per_cu); per_cu = 1; }
        grid = cus;
    }
    if (grid < 0) return;
    hipMemsetAsync((char*)d_ws + WS_CTL, 0, CTL_BYTES, stream);
    Params p{};
    p.x = (const float*)d_in[0]; p.ln_e = (const float*)d_in[1]; p.w_in_e = (const float*)d_in[2]; p.qkn_e = (const float*)d_in[3]; p.lam_e = (const float*)d_in[4];
    p.subln_e = (const float*)d_in[5]; p.w_out_e = (const float*)d_in[6]; p.ln_o = (const float*)d_in[7]; p.w_in_o = (const float*)d_in[8]; p.qkn_o = (const float*)d_in[9];
    p.phi_pe = (const float*)d_in[10]; p.phi_w1 = (const float*)d_in[11]; p.phi_w2 = (const float*)d_in[12]; p.w_out_o = (const float*)d_in[13];
    p.out = (float*)d_out; p.ws = (unsigned char*)d_ws;
#if MK_LAUNCHES == 1
    p.ph_lo = 0; p.ph_hi = 8;
    void* args[] = {&p};
    hipError_t e = hipLaunchCooperativeKernel((const void*)mk_fwd, dim3(grid), dim3(NTHREADS), args, LDS_BYTES, stream);
    if (e != hipSuccess) fprintf(stderr, "cooperative launch failed: %s (grid %d)\n", hipGetErrorString(e), grid);
#else
    for (int ph = 0; ph < 8; ++ph) { p.ph_lo = ph; p.ph_hi = ph + 1; hipLaunchKernelGGL(mk_fwd, dim3(grid), dim3(NTHREADS), LDS_BYTES, stream, p); }
#endif
}
```
